# Optimizing an MI355X kernel written in HIP

```python
import math
import jax, jax.numpy as jnp
from jax import lax
import numpy as np

D_MODEL = 2048
BATCH = 4
SEQ = 4096
DEPTH = 1

D_ATTN = D_MODEL // 2
D_LRU = D_MODEL - D_ATTN
HEAD_DIM = 64
N_HEADS = D_ATTN // HEAD_DIM
DILATED_PATTERNS = ((128, 1), (512, 4), (2048, 16))
LRU_BLOCKS = 16
LRU_BLOCK_DIM = D_LRU // LRU_BLOCKS
CONV_WIDTH = 4
RG_C = 8.0
D_PROJ = 3 * D_ATTN + 2 * D_LRU
N_GROUPS = 4
EXPERTS_PER_GROUP = 8
N_EXPERTS = N_GROUPS * EXPERTS_PER_GROUP
TOP_K = 2
D_EXPERT = 512
MOE_BLOCK = 128
ALPHA = (2.0 * DEPTH) ** 0.25
BETA = (8.0 * DEPTH) ** -0.25
LN_EPS = 1e-5
RMS_EPS = 1e-6

kernel_name = "hymba_dilated_rglru_hmoe_deepnorm"


def _layer_norm(x, g, b):
    xf = x.astype(jnp.float32)
    mu = jnp.mean(xf, axis=-1, keepdims=True)
    var = jnp.mean(jnp.square(xf - mu), axis=-1, keepdims=True)
    return ((xf - mu) * lax.rsqrt(var + LN_EPS) * g.astype(jnp.float32) + b.astype(jnp.float32)).astype(x.dtype)


def _rms_norm(x, g):
    xf = x.astype(jnp.float32)
    return xf * lax.rsqrt(jnp.mean(jnp.square(xf), axis=-1, keepdims=True) + RMS_EPS) * g.astype(jnp.float32)


def _dilated_band_attention(q, k, v, slopes, window, dilation):
    B, S, H, Dh = q.shape
    w = window // dilation
    L = S // dilation
    nb = -(-L // w)
    Lp = nb * w

    def to_sub(t):
        t = t.reshape(B, L, dilation, H, Dh).transpose(0, 2, 1, 3, 4).reshape(B * dilation, L, H, Dh)
        t = jnp.pad(t, ((0, 0), (0, Lp - L), (0, 0), (0, 0)))
        return t.reshape(B * dilation, nb, w, H, Dh)

    def with_prev(t):
        prev = jnp.pad(t[:, :-1], ((0, 0), (1, 0), (0, 0), (0, 0), (0, 0)))
        return jnp.concatenate([prev, t], axis=2)

    qb = to_sub(q)
    kk = with_prev(to_sub(k))
    vv = with_prev(to_sub(v))
    s = jnp.einsum('bnqhd,bnkhd->bnhqk', qb, kk)
    qi = jnp.arange(w)[:, None]
    ki = jnp.arange(2 * w)[None, :]
    dist = qi + w - ki
    blk = jnp.arange(nb)[:, None, None]
    valid = (dist >= 0) & (dist <= w) & (blk * w + ki - w >= 0)
    bias = -slopes[:, None, None] * (dist * dilation).astype(jnp.float32)[None]
    s = jnp.where(valid[None, :, None], s + bias[None, None], -jnp.inf)
    m = jnp.max(s, axis=-1, keepdims=True)
    p = jnp.exp(s - m)
    l = jnp.sum(p, axis=-1, keepdims=True)
    o = jnp.einsum('bnhqk,bnkhd->bnqhd', p / l, vv)
    lse = (m + jnp.log(l))[..., 0].transpose(0, 1, 3, 2)
    o = o.reshape(B, dilation, Lp, H, Dh)[:, :, :L].transpose(0, 2, 1, 3, 4).reshape(B, S, H, Dh)
    lse = lse.reshape(B, dilation, Lp, H)[:, :, :L].transpose(0, 2, 1, 3).reshape(B, S, H)
    return o, lse


def _causal_depthwise_conv(x, w, b):
    S = x.shape[1]
    xp = jnp.pad(x, ((0, 0), (CONV_WIDTH - 1, 0), (0, 0)))
    y = b
    for j in range(CONV_WIDTH):
        y = y + xp[:, j:j + S] * w[j]
    return y


def _rg_lru(x, wa, ba, wx, bx, lam):
    B, S, C = x.shape
    xb = x.reshape(B, S, LRU_BLOCKS, LRU_BLOCK_DIM)
    r = jax.nn.sigmoid(jnp.einsum('bsnd,nde->bsne', xb, wa) + ba).reshape(B, S, C)
    i = jax.nn.sigmoid(jnp.einsum('bsnd,nde->bsne', xb, wx) + bx).reshape(B, S, C)
    log_a = -RG_C * r * jax.nn.softplus(-lam)
    a = jnp.exp(log_a)
    u = jnp.sqrt(-jnp.expm1(2.0 * log_a)) * (i * x)

    def combine(c1, c2):
        a1, b1 = c1
        a2, b2 = c2
        return a1 * a2, a2 * b1 + b2

    _, h = lax.associative_scan(combine, (a, u), axis=1)
    return h


def _hybrid_mixer(x, w_in, conv_w, conv_b, lru_wa, lru_ba, lru_wx, lru_bx, lru_lambda,
                  attn_norm_g, lru_norm_g, w_out):
    B, S, _ = x.shape
    f32 = jnp.float32
    proj = jnp.einsum('bsd,de->bse', x, w_in)
    q, k, v, xr, xg = jnp.split(proj, [D_ATTN, 2 * D_ATTN, 3 * D_ATTN, 3 * D_ATTN + D_LRU], axis=-1)
    q = q.reshape(B, S, N_HEADS, HEAD_DIM).astype(f32) * (HEAD_DIM ** -0.5)
    k = k.reshape(B, S, N_HEADS, HEAD_DIM).astype(f32)
    v = v.reshape(B, S, N_HEADS, HEAD_DIM).astype(f32)
    slopes = jnp.exp2(-8.0 * jnp.arange(1, N_HEADS + 1, dtype=f32) / N_HEADS)
    outs, lses = [], []
    for window, dilation in DILATED_PATTERNS:
        o, l = _dilated_band_attention(q, k, v, slopes, window, dilation)
        outs.append(o)
        lses.append(l)
    wts = jax.nn.softmax(jnp.stack(lses), axis=0)
    attn = jnp.sum(wts[..., None] * jnp.stack(outs), axis=0).reshape(B, S, D_ATTN)
    xr = _causal_depthwise_conv(xr.astype(f32), conv_w.astype(f32), conv_b.astype(f32))
    h = _rg_lru(xr, lru_wa.astype(f32), lru_ba.astype(f32), lru_wx.astype(f32), lru_bx.astype(f32),
                lru_lambda.astype(f32))
    rec = h * jax.nn.gelu(xg.astype(f32))
    y = jnp.concatenate([_rms_norm(attn, attn_norm_g), _rms_norm(rec, lru_norm_g)], axis=-1).astype(x.dtype)
    return jnp.einsum('bse,ed->bsd', y, w_out)


def _hier_moe(x2d, grp_w, grp_b, exp_w, exp_b, w1, w3, w2):
    T, D = x2d.shape
    f32 = jnp.float32
    xf = x2d.astype(f32)
    p_grp = jax.nn.softmax(xf @ grp_w.astype(f32) + grp_b.astype(f32), axis=-1)
    g_idx = jnp.argmax(p_grp, axis=-1)
    g_gate = jnp.take_along_axis(p_grp, g_idx[:, None], axis=-1)
    e_logits = (xf @ exp_w.astype(f32) + exp_b.astype(f32)).reshape(T, N_GROUPS, EXPERTS_PER_GROUP)
    e_logits = jnp.take_along_axis(e_logits, g_idx[:, None, None], axis=1)[:, 0]
    top_v, top_i = lax.top_k(jax.nn.softmax(e_logits, axis=-1), TOP_K)
    weights = g_gate * top_v / jnp.sum(top_v, axis=-1, keepdims=True)
    e_flat = (g_idx[:, None] * EXPERTS_PER_GROUP + top_i).reshape(-1).astype(jnp.int32)
    w_flat = weights.reshape(-1).astype(x2d.dtype)
    tok_flat = jnp.repeat(jnp.arange(T, dtype=jnp.int32), TOP_K)
    order = jnp.argsort(e_flat)
    e_sorted, tok_sorted, w_sorted = e_flat[order], tok_flat[order], w_flat[order]
    counts = jnp.zeros((N_EXPERTS,), jnp.int32).at[e_flat].add(1)
    padded = (counts + MOE_BLOCK - 1) // MOE_BLOCK * MOE_BLOCK
    pad_end = jnp.cumsum(padded)
    pad_start = pad_end - padded
    start = jnp.cumsum(counts) - counts
    dest = pad_start[e_sorted] + (jnp.arange(T * TOP_K, dtype=jnp.int32) - start[e_sorted])
    P = ((T * TOP_K + MOE_BLOCK - 1) // MOE_BLOCK + N_EXPERTS) * MOE_BLOCK
    buf_tok = jnp.full((P,), T, jnp.int32).at[dest].set(tok_sorted)
    buf_w = jnp.zeros((P,), x2d.dtype).at[dest].set(w_sorted)
    n_blk = P // MOE_BLOCK
    blk_e = jnp.minimum(jnp.searchsorted(pad_end, jnp.arange(n_blk, dtype=jnp.int32) * MOE_BLOCK, side='right'),
                        N_EXPERTS - 1)
    x_pad = jnp.concatenate([x2d, jnp.zeros((1, D), x2d.dtype)], axis=0)
    xb = x_pad[buf_tok].reshape(n_blk, MOE_BLOCK, D)

    def expert_block(args):
        xblk, e = args
        return (jax.nn.silu(xblk @ w1[e]) * (xblk @ w3[e])) @ w2[e]

    yb = lax.map(expert_block, (xb, blk_e)).reshape(P, D)
    out = jnp.zeros((T + 1, D), x2d.dtype).at[buf_tok].add(yb * buf_w[:, None])
    return out[:T]


def setup_inputs(seed: int = 0) -> dict:
    key = jax.random.key(seed)
    ks = jax.random.split(key, 24)
    f32 = jnp.float32
    nrm = lambda k, shape, s: jax.random.normal(k, shape, f32) * s
    col_scale = jnp.concatenate([jnp.ones((2 * D_ATTN,), f32), jnp.full((D_ATTN,), BETA, f32),
                                 jnp.ones((2 * D_LRU,), f32)])
    a0 = jax.random.uniform(ks[8], (DEPTH, D_LRU), f32, 0.9, 0.999)
    sa = a0 ** (1.0 / RG_C)
    return {
        "x": nrm(ks[0], (BATCH, SEQ, D_MODEL), 1.0),
        "w_in": nrm(ks[1], (DEPTH, D_MODEL, D_PROJ), D_MODEL ** -0.5) * col_scale,
        "conv_w": nrm(ks[2], (DEPTH, CONV_WIDTH, D_LRU), CONV_WIDTH ** -0.5),
        "conv_b": nrm(ks[3], (DEPTH, D_LRU), 0.02),
        "lru_wa": nrm(ks[4], (DEPTH, LRU_BLOCKS, LRU_BLOCK_DIM, LRU_BLOCK_DIM), LRU_BLOCK_DIM ** -0.5),
        "lru_ba": nrm(ks[5], (DEPTH, LRU_BLOCKS, LRU_BLOCK_DIM), 0.02),
        "lru_wx": nrm(ks[6], (DEPTH, LRU_BLOCKS, LRU_BLOCK_DIM, LRU_BLOCK_DIM), LRU_BLOCK_DIM ** -0.5),
        "lru_bx": nrm(ks[7], (DEPTH, LRU_BLOCKS, LRU_BLOCK_DIM), 0.02),
        "lru_lambda": jnp.log(sa) - jnp.log1p(-sa),
        "attn_norm_g": 1.0 + nrm(ks[9], (DEPTH, D_ATTN), 0.02),
        "lru_norm_g": 1.0 + nrm(ks[10], (DEPTH, D_LRU), 0.02),
        "w_out": nrm(ks[11], (DEPTH, D_MODEL, D_MODEL), BETA * D_MODEL ** -0.5),
        "ln1_g": 1.0 + nrm(ks[12], (DEPTH, D_MODEL), 0.02),
        "ln1_b": nrm(ks[13], (DEPTH, D_MODEL), 0.02),
        "router_grp_w": nrm(ks[14], (DEPTH, D_MODEL, N_GROUPS), D_MODEL ** -0.5),
        "router_grp_b": nrm(ks[15], (DEPTH, N_GROUPS), 0.01),
        "router_exp_w": nrm(ks[16], (DEPTH, D_MODEL, N_EXPERTS), D_MODEL ** -0.5),
        "router_exp_b": nrm(ks[17], (DEPTH, N_EXPERTS), 0.01),
        "w1": nrm(ks[18], (DEPTH, N_EXPERTS, D_MODEL, D_EXPERT), D_MODEL ** -0.5),
        "w3": nrm(ks[19], (DEPTH, N_EXPERTS, D_MODEL, D_EXPERT), D_MODEL ** -0.5),
        "w2": nrm(ks[20], (DEPTH, N_EXPERTS, D_EXPERT, D_MODEL), BETA * D_EXPERT ** -0.5),
        "ln2_g": 1.0 + nrm(ks[21], (DEPTH, D_MODEL), 0.02),
        "ln2_b": nrm(ks[22], (DEPTH, D_MODEL), 0.02),
    }


def reference(x, w_in, conv_w, conv_b, lru_wa, lru_ba, lru_wx, lru_bx, lru_lambda, attn_norm_g, lru_norm_g,
              w_out, ln1_g, ln1_b, router_grp_w, router_grp_b, router_exp_w, router_exp_b, w1, w3, w2,
              ln2_g, ln2_b):
    B, S, D = x.shape
    for layer in range(DEPTH):
        mix = _hybrid_mixer(x, w_in[layer], conv_w[layer], conv_b[layer], lru_wa[layer], lru_ba[layer],
                            lru_wx[layer], lru_bx[layer], lru_lambda[layer], attn_norm_g[layer],
                            lru_norm_g[layer], w_out[layer])
        x = _layer_norm(ALPHA * x + mix, ln1_g[layer], ln1_b[layer])
        moe = _hier_moe(x.reshape(B * S, D), router_grp_w[layer], router_grp_b[layer], router_exp_w[layer],
                        router_exp_b[layer], w1[layer], w3[layer], w2[layer]).reshape(B, S, D)
        x = _layer_norm(ALPHA * x + moe, ln2_g[layer], ln2_b[layer])
    return x
```

```cpp
#include <hip/hip_runtime.h>
#include <stdint.h>
#include <stdio.h>

#define GAS __attribute__((address_space(1)))
#define LAS __attribute__((address_space(3)))
typedef unsigned short bf16_t;
typedef unsigned v4u __attribute__((ext_vector_type(4)));
typedef unsigned v2u __attribute__((ext_vector_type(2)));
typedef float f32x4 __attribute__((ext_vector_type(4)));

constexpr int T = 16384, SEQ = 4096, NBATCH = 4, D = 2048, DP = 5120, DA = 1024, DL = 1024, NH = 16, HD = 64;
constexpr int NE = 32, DE = 512, NGRP = 4, EPG = 8;
constexpr int PMAX = 40960;
constexpr float ALPHA = 1.189207115002721f;
constexpr float LN_EPS = 1e-5f, RMS_EPS = 1e-6f;
constexpr int NWAVES = 8, NTHR = 512;
constexpr int LDS_BYTES = 163840, MISC_OFF = 131072 + 1024, BARST_OFF = 131072 + 2048;

constexpr size_t MiB = 1u << 20;
constexpr size_t WS_CTL = 0, CTL_BYTES = 1 * MiB;
constexpr size_t WS_WIN = 1 * MiB;
constexpr size_t WS_WOUT = 21 * MiB;
constexpr size_t WS_W13 = 29 * MiB;
constexpr size_t WS_Y = 93 * MiB;
constexpr size_t WS_W2 = 157 * MiB;
constexpr size_t WS_B = 221 * MiB;
constexpr size_t WS_X1B_OFF = 64 * MiB;
constexpr size_t WS_D = 381 * MiB;
constexpr size_t WS_LSE = 445 * MiB;
constexpr size_t WS_SSQR = 448 * MiB;
constexpr size_t WS_ROUTE = 452 * MiB;
constexpr size_t WS_X1F = 456 * MiB;
constexpr size_t WS_X8 = 520 * MiB;
constexpr size_t WS_END = 552 * MiB;
constexpr size_t RT_E = 0;
constexpr size_t RT_W = 131072;
constexpr size_t RT_RANK = 262144;
constexpr size_t RT_POS = 393216;
constexpr size_t RT_ROWTOK = 2097152;
constexpr size_t RT_WR = 1048576;
constexpr int CW_CNT = 64;
constexpr int CW_BAR = 4096;
constexpr int CW_QHEAD = 128;
constexpr int CW_READY = 8192;

constexpr size_t DO_O = 0, DO_OSTRIDE = (size_t)T * DA * 2, DO_REC = 3 * DO_OSTRIDE;

__device__ __forceinline__ float bf2f(bf16_t b) { return __uint_as_float(((unsigned)b) << 16); }
__device__ __forceinline__ unsigned f2bf(float f) { unsigned u = __float_as_uint(f); return (u + 0x7fffu + ((u >> 16) & 1u)) >> 16; }
__device__ __forceinline__ unsigned pk2(float lo, float hi) { unsigned r; asm("v_cvt_pk_bf16_f32 %0, %1, %2" : "=v"(r) : "v"(lo), "v"(hi)); return r; }
__device__ __forceinline__ float wave_sum(float v) {
#pragma unroll
    for (int o = 1; o < 64; o <<= 1) v += __shfl_xor(v, o);
    return v;
}
__device__ __forceinline__ float sigmoidf_(float x) { return 1.f / (1.f + __expf(-x)); }
__device__ __forceinline__ float gelu_tanh(float x) { const float u = 0.7978845608028654f * (x + 0.044715f * x * x * x); return 0.5f * x * (1.f + tanhf(u)); }

struct Args {
    const float* in[23];
    float* out;
    unsigned char* ws;
    int lo, hi;
};

struct Frame {
    LAS unsigned char* lds;
    int tid, lane, wave, gw, ngw;
};

__device__ __forceinline__ void transpose_item(const float* W, int K, int N, bf16_t* WT, int mode, LAS unsigned char* scr, int item, int lane, int nscaled = 0, float sc = 1.f) {
    const int kblk = K / 64, nb = item / kblk, kb = item - nb * kblk, k0 = 64 * kb, n0 = 64 * nb;
    int drow0 = n0;
    if (mode == 1) drow0 = (n0 / 128) * 256 + (n0 % 128);
    if (mode == 2) drow0 = (n0 / 128) * 256 + 128 + (n0 % 128);
    const int r4 = lane >> 4, c = lane & 15;
    const float scl = (n0 < nscaled) ? sc : 1.f;
    f32x4 v[16];
    const float* src = W + (size_t)(k0 + 2 * r4) * N + n0 + 4 * c;
#pragma unroll
    for (int j = 0; j < 8; ++j) { v[2 * j] = *(const f32x4*)(src + (size_t)(8 * j) * N); v[2 * j + 1] = *(const f32x4*)(src + (size_t)(8 * j + 1) * N); }
#pragma unroll
    for (int j = 0; j < 8; ++j)
#pragma unroll
        for (int q = 0; q < 4; ++q) { const int n = 4 * c + q;
            *(LAS unsigned*)(scr + n * 128 + ((j ^ (c & 7)) << 4) + 4 * r4) = pk2(v[2 * j][q] * scl, v[2 * j + 1][q] * scl); }
    asm volatile("s_waitcnt lgkmcnt(0)" ::: "memory");
    const int ch = lane & 7;
#pragma unroll
    for (int j = 0; j < 8; ++j) { const int n = 8 * j + (lane >> 3);
        const v4u o = *(const LAS v4u*)(scr + n * 128 + ((ch ^ ((n >> 2) & 7)) << 4));
        *(v4u*)(WT + (size_t)(drow0 + n) * K + k0 + 8 * ch) = o; }
    asm volatile("s_waitcnt lgkmcnt(0)" ::: "memory");
}

__device__ __forceinline__ void phase_convert(const Frame& F, const Args& a) {
    unsigned char* ws = a.ws;
    {
        const float* x = a.in[0]; bf16_t* xb = (bf16_t*)(ws + WS_D);
        const size_t nch = (size_t)T * D / 8;
        for (size_t i = (size_t)F.gw * 256 + F.lane; i < nch; i += (size_t)F.ngw * 256) {
            f32x4 v0[4], v1[4];
#pragma unroll
            for (int q = 0; q < 4; ++q) { v0[q] = *(const f32x4*)(x + (i + 64 * q) * 8); v1[q] = *(const f32x4*)(x + (i + 64 * q) * 8 + 4); }
#pragma unroll
            for (int q = 0; q < 4; ++q) { v4u o; o.x = pk2(v0[q].x, v0[q].y); o.y = pk2(v0[q].z, v0[q].w); o.z = pk2(v1[q].x, v1[q].y); o.w = pk2(v1[q].z, v1[q].w);
                *(v4u*)(xb + (i + 64 * q) * 8) = o; }
        }
    }
    {
        bf16_t* WrT = (bf16_t*)(ws + WS_ROUTE + RT_WR);
        for (int idx = F.gw * 64 + F.lane; idx < 48 * D; idx += F.ngw * 64) {
            const int j = idx & 7, ln = (idx >> 3) & 63, blk = idx >> 9;
            const int nt = blk % 3, wk = blk / 3, col = 16 * nt + (ln & 15), k = 32 * wk + 8 * (ln >> 4) + j;
            const float wv = (col < 4) ? a.in[14][k * NGRP + col] : ((col < 36) ? a.in[16][k * NE + (col - 4)] : 0.f);
            const unsigned hb = pk2(wv, 0.f) & 0xffffu; const float hf = __uint_as_float(hb << 16);
            WrT[(size_t)(2 * blk) * 512 + ln * 8 + j] = (bf16_t)hb; WrT[(size_t)(2 * blk + 1) * 512 + ln * 8 + j] = (bf16_t)(pk2(wv - hf, 0.f) & 0xffffu); }
    }
    LAS unsigned char* scr = F.lds + F.wave * 8192;
    constexpr int I_IN = (D / 64) * (DP / 64);
    { const int run = (I_IN + F.ngw - 1) / F.ngw; for (int r = 0; r < run; ++r) { const int it = F.gw * run + r; if (it < I_IN) transpose_item(a.in[1], D, DP, (bf16_t*)(ws + WS_WIN), 0, scr, it, F.lane, DA, 0.125f * 1.4426950408889634f); } }
}
__device__ __forceinline__ void transpose_item8(const float* W, int K, int N, unsigned char* WT, int mode, LAS unsigned char* scr, int item, int lane) {
    const int kblk = K / 64, nb = item / kblk, kb = item - nb * kblk, k0 = 64 * kb, n0 = 64 * nb;
    int drow0 = n0;
    if (mode == 1) drow0 = (n0 / 128) * 256 + (n0 % 128);
    if (mode == 2) drow0 = (n0 / 128) * 256 + 128 + (n0 % 128);
    const int r4 = lane >> 4, c = lane & 15;
    f32x4 v[16];
    const float* src = W + (size_t)(k0 + 4 * r4) * N + n0 + 4 * c;
#pragma unroll
    for (int j = 0; j < 4; ++j)
#pragma unroll
        for (int s4 = 0; s4 < 4; ++s4) v[4 * j + s4] = *(const f32x4*)(src + (size_t)(16 * j + s4) * N);
#pragma unroll
    for (int j = 0; j < 4; ++j)
#pragma unroll
        for (int q = 0; q < 4; ++q) { const int n = 4 * c + q;
            int pk = 0;
            pk = __builtin_amdgcn_cvt_pk_fp8_f32(v[4 * j][q] * 64.f, v[4 * j + 1][q] * 64.f, pk, false);
            pk = __builtin_amdgcn_cvt_pk_fp8_f32(v[4 * j + 2][q] * 64.f, v[4 * j + 3][q] * 64.f, pk, true);
            *(LAS int*)(scr + n * 64 + ((j ^ (c & 3)) << 4) + 4 * r4) = pk; }
    asm volatile("s_waitcnt lgkmcnt(0)" ::: "memory");
    const int pch = lane & 3;
#pragma unroll
    for (int j = 0; j < 4; ++j) { const int n = 16 * j + (lane >> 2);
        const v4u o = *(const LAS v4u*)(scr + n * 64 + ((pch ^ ((n >> 2) & 3)) << 4));
        *(v4u*)(WT + (size_t)(drow0 + n) * K + k0 + 16 * pch) = o; }
    asm volatile("s_waitcnt lgkmcnt(0)" ::: "memory");
}
__device__ __forceinline__ void convert_rest(const Frame& F, const Args& a) {
    unsigned char* ws = a.ws;
    LAS unsigned char* scr = F.lds + F.wave * 8192;
    constexpr int I_OUT = (D / 64) * (D / 64), I_E13 = (D / 64) * (DE / 64), I_E2 = (DE / 64) * (D / 64);
    constexpr int NITEMS = I_OUT + NE * (2 * I_E13 + I_E2);
    const int run_ = (NITEMS + F.ngw - 1) / F.ngw;
    for (int rr_ = 0; rr_ < run_; ++rr_) {
        const int it = F.gw * run_ + rr_; if (it >= NITEMS) break;
        int r = it;
        if (r < I_OUT) { transpose_item(a.in[11], D, D, (bf16_t*)(ws + WS_WOUT), 0, scr, r, F.lane); continue; } r -= I_OUT;
        const int per_e = 2 * I_E13 + I_E2, e = r / per_e; r -= e * per_e;
        if (r < I_E13) { transpose_item8(a.in[18] + (size_t)e * D * DE, D, DE, (unsigned char*)(ws + WS_W13) + (size_t)e * 1024 * D, 1, scr, r, F.lane); continue; } r -= I_E13;
        if (r < I_E13) { transpose_item8(a.in[19] + (size_t)e * D * DE, D, DE, (unsigned char*)(ws + WS_W13) + (size_t)e * 1024 * D, 2, scr, r, F.lane); continue; } r -= I_E13;
        transpose_item8(a.in[20] + (size_t)e * DE * D, DE, D, (unsigned char*)(ws + WS_W2) + (size_t)e * D * DE, 0, scr, r, F.lane);
    }
}

__device__ __forceinline__ void phase_combine(const Frame& F, const Args& a) {
    const unsigned char* dob = (const unsigned char*)a.out;
    const float* lse = (const float*)(a.ws + WS_LSE);
    bf16_t* y = (bf16_t*)(a.ws + WS_Y);
    const int lane = F.lane, h = lane >> 2;
    float gav[16], grv[16];
#pragma unroll
    for (int j = 0; j < 4; ++j) { const f32x4 ta = *(const f32x4*)(a.in[9] + 16 * lane + 4 * j), tr = *(const f32x4*)(a.in[10] + 16 * lane + 4 * j);
        gav[4 * j] = ta.x; gav[4 * j + 1] = ta.y; gav[4 * j + 2] = ta.z; gav[4 * j + 3] = ta.w; grv[4 * j] = tr.x; grv[4 * j + 1] = tr.y; grv[4 * j + 2] = tr.z; grv[4 * j + 3] = tr.w; }
    for (int t = F.gw; t < T; t += F.ngw) {
        const float l0 = lse[(size_t)(0 * T + t) * NH + h], l1 = lse[(size_t)(1 * T + t) * NH + h], l2 = lse[(size_t)(2 * T + t) * NH + h];
        v4u oa[3][2], rr[2];
#pragma unroll
        for (int pp = 0; pp < 3; ++pp) { const v4u* po = (const v4u*)(dob + DO_O + (size_t)pp * DO_OSTRIDE + ((size_t)t * DA + 16 * lane) * 2); oa[pp][0] = po[0]; oa[pp][1] = po[1]; }
        { const v4u* pr = (const v4u*)(dob + DO_REC + ((size_t)t * DL + 16 * lane) * 2); rr[0] = pr[0]; rr[1] = pr[1]; }
        const float mx = fmaxf(l0, fmaxf(l1, l2));
        float w0 = __expf(l0 - mx), w1 = __expf(l1 - mx), w2 = __expf(l2 - mx);
        const float inv = 1.f / (w0 + w1 + w2); w0 *= inv; w1 *= inv; w2 *= inv;
        float v[16], rv[16]; float ss = 0.f, sr = 0.f;
#pragma unroll
        for (int q = 0; q < 2; ++q)
#pragma unroll
            for (int j = 0; j < 4; ++j) {
                const unsigned u0 = oa[0][q][j], u1 = oa[1][q][j], u2 = oa[2][q][j], ur = rr[q][j];
                const float lo = w0 * __uint_as_float(u0 << 16) + w1 * __uint_as_float(u1 << 16) + w2 * __uint_as_float(u2 << 16);
                const float hi = w0 * __uint_as_float(u0 & 0xffff0000u) + w1 * __uint_as_float(u1 & 0xffff0000u) + w2 * __uint_as_float(u2 & 0xffff0000u);
                v[q * 8 + 2 * j] = lo; v[q * 8 + 2 * j + 1] = hi; ss += lo * lo + hi * hi;
                const float rl = __uint_as_float(ur << 16), rh = __uint_as_float(ur & 0xffff0000u);
                rv[q * 8 + 2 * j] = rl; rv[q * 8 + 2 * j + 1] = rh; sr += rl * rl + rh * rh;
            }
        ss = wave_sum(ss); sr = wave_sum(sr);
        const float rsa = 1.f / sqrtf(ss * (1.f / DA) + RMS_EPS), rsr = 1.f / sqrtf(sr * (1.f / DL) + RMS_EPS);
        v4u o[2], o2[2];
#pragma unroll
        for (int q = 0; q < 2; ++q)
#pragma unroll
            for (int j = 0; j < 4; ++j) { const int c = q * 8 + 2 * j;
                o[q][j] = pk2(v[c] * rsa * gav[c], v[c + 1] * rsa * gav[c + 1]); o2[q][j] = pk2(rv[c] * rsr * grv[c], rv[c + 1] * rsr * grv[c + 1]); }
        { v4u* dst = (v4u*)(y + (size_t)t * D + 16 * lane); dst[0] = o[0]; dst[1] = o[1]; }
        { v4u* dst = (v4u*)(y + (size_t)t * D + DA + 16 * lane); dst[0] = o2[0]; dst[1] = o2[1]; }
    }
}

constexpr int LN1_ROW = 8208;
__device__ __forceinline__ void phase_ln1_router(const Frame& F, const Args& a) {
    bf16_t* x1b = (bf16_t*)(a.ws + WS_X1F); unsigned char* x1f8 = (unsigned char*)(a.ws + WS_X8); const bf16_t* mixb = (const bf16_t*)(a.ws + WS_B); const bf16_t* xbb = (const bf16_t*)(a.ws + WS_D);
    const float* g1 = a.in[12]; const float* b1 = a.in[13];
    const float* gb = a.in[15]; const float* eb = a.in[17];
    const bf16_t* WrT = (const bf16_t*)(a.ws + WS_ROUTE + RT_WR);
    int* rt_e = (int*)(a.ws + WS_ROUTE + RT_E); float* rt_w = (float*)(a.ws + WS_ROUTE + RT_W); int* rt_rank = (int*)(a.ws + WS_ROUTE + RT_RANK);
    unsigned* cnt = (unsigned*)(a.ws + WS_CTL) + CW_CNT; int* rowtok = (int*)(a.ws + WS_ROUTE + RT_ROWTOK);
    const int lane = F.lane, i = lane & 15, g = lane >> 4, w = F.wave;
    LAS unsigned char* L = F.lds;
    LAS float* rbias = (LAS float*)(F.lds + 131072 + 3072);
    if (F.tid < 48) rbias[F.tid] = (F.tid < 4) ? gb[F.tid] : ((F.tid < 36) ? eb[F.tid - 4] : 0.f);
    LAS int* elist = (LAS int*)(F.lds + 131072 + 3584); LAS int* lcnt = elist + 64;
    LAS unsigned char* PT = F.lds + 131072 + 5120;
    for (int tb = blockIdx.x; tb < T / 64; tb += gridDim.x) {
        __syncthreads();
#pragma unroll 1
        for (int sb = 0; sb < 4; ++sb) {
            v2u xv2[2][8], mv2[2][8];
#pragma unroll
            for (int q = 0; q < 2; ++q)
#pragma unroll
                for (int j = 0; j < 8; ++j) { const size_t o = (size_t)(64 * tb + 16 * sb + 2 * w + q) * D + 4 * lane + 256 * j; xv2[q][j] = *(const v2u*)(xbb + o); mv2[q][j] = *(const v2u*)(mixb + o); }
#pragma unroll
            for (int q = 0; q < 2; ++q) {
                const int tl = 2 * w + q, t = 64 * tb + 16 * sb + tl;
                f32x4 v[8]; float s = 0.f;
#pragma unroll
                for (int j = 0; j < 8; ++j) { const v2u xq = xv2[q][j]; const v2u mq = mv2[q][j];
                    v[j].x = ALPHA * __uint_as_float(xq.x << 16) + __uint_as_float(mq.x << 16); v[j].y = ALPHA * __uint_as_float(xq.x & 0xffff0000u) + __uint_as_float(mq.x & 0xffff0000u);
                    v[j].z = ALPHA * __uint_as_float(xq.y << 16) + __uint_as_float(mq.y << 16); v[j].w = ALPHA * __uint_as_float(xq.y & 0xffff0000u) + __uint_as_float(mq.y & 0xffff0000u);
                    s += (v[j].x + v[j].y) + (v[j].z + v[j].w); }
                const float mean = wave_sum(s) * (1.f / D); float s2 = 0.f;
#pragma unroll
                for (int j = 0; j < 8; ++j) { v[j] = v[j] - mean; s2 += (v[j].x * v[j].x + v[j].y * v[j].y) + (v[j].z * v[j].z + v[j].w * v[j].w); }
                const float rstd = 1.f / sqrtf(wave_sum(s2) * (1.f / D) + LN_EPS);
#pragma unroll
                for (int jh = 0; jh < 2; ++jh) {
                    f32x4 gg[4], bb[4];
#pragma unroll
                    for (int j4 = 0; j4 < 4; ++j4) { const int c = 4 * lane + 256 * (4 * jh + j4); gg[j4] = *(const f32x4*)(g1 + c); bb[j4] = *(const f32x4*)(b1 + c); }
#pragma unroll
                    for (int j4 = 0; j4 < 4; ++j4) {
                        const int j = 4 * jh + j4, c = 4 * lane + 256 * j;
                        v[j] = v[j] * rstd * gg[j4] + bb[j4];
                        *(LAS f32x4*)(L + tl * LN1_ROW + c * 4) = v[j];
                        v2u o; o.x = pk2(v[j].x, v[j].y); o.y = pk2(v[j].z, v[j].w);
                        *(v2u*)(x1b + (size_t)t * D + c) = o;
                        int p8 = 0; p8 = __builtin_amdgcn_cvt_pk_fp8_f32(v[j].x, v[j].y, p8, false); p8 = __builtin_amdgcn_cvt_pk_fp8_f32(v[j].z, v[j].w, p8, true);
                        *(int*)(x1f8 + (size_t)t * D + c) = p8;
                    }
                }
            }
            __syncthreads();
            f32x4 c0 = (f32x4){0.f, 0.f, 0.f, 0.f}, c1 = c0, c2 = c0;
            {
                typedef short bf16x8_ __attribute__((ext_vector_type(8)));
                const LAS unsigned char* xa = L + i * LN1_ROW + (256 * w + 8 * g) * 4;
                const bf16_t* wb = WrT + (size_t)(w * 8) * 3 * 2 * 512 + lane * 8;
                v4u wf[6], wn[6];
#define LN1_LDW(dst, ks_) do { _Pragma("unroll") for (int nt = 0; nt < 3; ++nt) { dst[2 * nt] = *(const v4u*)(wb + (size_t)((((ks_) * 3 + nt) * 2) * 512)); dst[2 * nt + 1] = *(const v4u*)(wb + (size_t)((((ks_) * 3 + nt) * 2 + 1) * 512)); } } while (0)
                LN1_LDW(wf, 0);
#pragma unroll
                for (int ks = 0; ks < 8; ++ks) {
                    if (ks + 1 < 8) LN1_LDW(wn, ks + 1);
                    const f32x4 x0 = *(const LAS f32x4*)(xa + 128 * ks), x1 = *(const LAS f32x4*)(xa + 128 * ks + 16);
                    v4u hi, lo;
                    hi.x = pk2(x0.x, x0.y); hi.y = pk2(x0.z, x0.w); hi.z = pk2(x1.x, x1.y); hi.w = pk2(x1.z, x1.w);
                    lo.x = pk2(x0.x - __uint_as_float(hi.x << 16), x0.y - __uint_as_float(hi.x & 0xffff0000u)); lo.y = pk2(x0.z - __uint_as_float(hi.y << 16), x0.w - __uint_as_float(hi.y & 0xffff0000u));
                    lo.z = pk2(x1.x - __uint_as_float(hi.z << 16), x1.y - __uint_as_float(hi.z & 0xffff0000u)); lo.w = pk2(x1.z - __uint_as_float(hi.w << 16), x1.w - __uint_as_float(hi.w & 0xffff0000u));
                    const bf16x8_ ah = __builtin_bit_cast(bf16x8_, hi), al = __builtin_bit_cast(bf16x8_, lo);
#define LN1_RT(cacc, nt) do { const bf16x8_ wh = __builtin_bit_cast(bf16x8_, wf[2 * (nt)]), wl = __builtin_bit_cast(bf16x8_, wf[2 * (nt) + 1]); \
                        cacc = __builtin_amdgcn_mfma_f32_16x16x32_bf16(ah, wh, cacc, 0, 0, 0); cacc = __builtin_amdgcn_mfma_f32_16x16x32_bf16(ah, wl, cacc, 0, 0, 0); cacc = __builtin_amdgcn_mfma_f32_16x16x32_bf16(al, wh, cacc, 0, 0, 0); } while (0)
                    LN1_RT(c0, 0); LN1_RT(c1, 1); LN1_RT(c2, 2);
#undef LN1_RT
#pragma unroll
                    for (int q6 = 0; q6 < 6; ++q6) wf[q6] = wn[q6];
                }
#undef LN1_LDW
            }
            { LAS f32x4* xp = (LAS f32x4*)(PT + (w * 64 + lane) * 48); xp[0] = c0; xp[1] = c1; xp[2] = c2; }
            __syncthreads();
            if (w == 0) {
                const float bias0 = rbias[i], bias1 = rbias[16 + i], bias2 = rbias[32 + i];
                c0 = (f32x4){0.f, 0.f, 0.f, 0.f}; c1 = c0; c2 = c0;
#pragma unroll
                for (int w2 = 0; w2 < 8; ++w2) { const LAS f32x4* xp = (const LAS f32x4*)(PT + (w2 * 64 + lane) * 48); c0 += xp[0]; c1 += xp[1]; c2 += xp[2]; }
                LAS float* lgs = (LAS float*)(PT + 24576);
#pragma unroll
                for (int r = 0; r < 4; ++r) { LAS float* lp = lgs + (4 * g + r) * 48 + i; lp[0] = c0[r] + bias0; lp[16] = c1[r] + bias1; lp[32] = c2[r] + bias2; }
                asm volatile("s_waitcnt lgkmcnt(0)" ::: "memory");
                if (lane < 16) {
                    const int t = 64 * tb + 16 * sb + lane;
                    const LAS float* lp = lgs + lane * 48;
                    float pg[4]; float mg = -1e30f; int gi = 0;
#pragma unroll
                    for (int gq = 0; gq < 4; ++gq) { pg[gq] = lp[gq]; if (pg[gq] > mg) { mg = pg[gq]; gi = gq; } }
                    float sg = 0.f;
#pragma unroll
                    for (int gq = 0; gq < 4; ++gq) sg += __expf(pg[gq] - mg);
                    const float ggate = 1.f / sg;
                    float el[8];
#pragma unroll
                    for (int e = 0; e < 8; ++e) el[e] = lp[4 + 8 * gi + e];
                    float m1 = -1e30f, m2 = -1e30f; int i1 = 0, i2 = 0;
#pragma unroll
                    for (int e = 0; e < 8; ++e) { if (el[e] > m1) { m2 = m1; i2 = i1; m1 = el[e]; i1 = e; } else if (el[e] > m2) { m2 = el[e]; i2 = e; } }
                    const float e2 = __expf(m2 - m1); const float wa = 1.f / (1.f + e2), wb2 = e2 / (1.f + e2);
                    const int ea = gi * EPG + i1, eb_ = gi * EPG + i2;
                    rt_e[2 * t] = ea; rt_e[2 * t + 1] = eb_;
                    rt_w[2 * t] = ggate * wa; rt_w[2 * t + 1] = ggate * wb2;
                    elist[16 * sb + lane] = ea | (eb_ << 8);
                }
            }
        }
        if (w == 0) {
            if (lane < 32) lcnt[lane] = 0;
            asm volatile("s_waitcnt lgkmcnt(0)" ::: "memory");
            const int ee = elist[lane], ea = ee & 255, eb_ = ee >> 8, t = 64 * tb + lane;
            const int la = (int)__hip_atomic_fetch_add(&lcnt[ea], 1, __ATOMIC_RELAXED, __HIP_MEMORY_SCOPE_WORKGROUP), lb = (int)__hip_atomic_fetch_add(&lcnt[eb_], 1, __ATOMIC_RELAXED, __HIP_MEMORY_SCOPE_WORKGROUP);
            asm volatile("s_waitcnt lgkmcnt(0)" ::: "memory");
            if (lane < 32) { const int c = lcnt[lane]; lcnt[32 + lane] = (c > 0) ? (int)atomicAdd(cnt + lane, (unsigned)c) : 0; }
            asm volatile("s_waitcnt vmcnt(0) lgkmcnt(0)" ::: "memory");
            const int ra = lcnt[32 + ea] + la, rb = lcnt[32 + eb_] + lb;
            rt_rank[2 * t] = ra; rt_rank[2 * t + 1] = rb;
            rowtok[ea * 16384 + ra] = t; rowtok[eb_ * 16384 + rb] = t;
        }
    }
    __syncthreads();
}

__device__ __forceinline__ void phase_final(const Frame& F, const Args& a) {
    float* outp = a.out; const unsigned char* Y = (const unsigned char*)(a.ws + WS_B); const bf16_t* x1b = (const bf16_t*)(a.ws + WS_X1F);
    const float* g2 = a.in[21]; const float* b2 = a.in[22];
    const int* rt_e = (const int*)(a.ws + WS_ROUTE + RT_E); const int* rt_rank = (const int*)(a.ws + WS_ROUTE + RT_RANK); const float* rt_w = (const float*)(a.ws + WS_ROUTE + RT_W);
    const LAS int* toff = (const LAS int*)(F.lds + MISC_OFF);
    const int lane = F.lane;
    typedef float f32x2_ __attribute__((ext_vector_type(2)));
    f32x4 gg[8], bb[8];
#pragma unroll
    for (int j = 0; j < 8; ++j) { const int c = 4 * lane + 256 * j; gg[j] = *(const f32x4*)(g2 + c); bb[j] = *(const f32x4*)(b2 + c); }
    int ne0 = 0, ne1 = 0, nr0 = 0, nr1 = 0; float nw0 = 0.f, nw1 = 0.f;
    if (F.gw < T) { const int t = F.gw; ne0 = rt_e[2 * t]; ne1 = rt_e[2 * t + 1]; nr0 = rt_rank[2 * t]; nr1 = rt_rank[2 * t + 1]; nw0 = rt_w[2 * t]; nw1 = rt_w[2 * t + 1]; }
    for (int t = F.gw; t < T; t += F.ngw) {
        const int p0 = toff[ne0] * 256 + nr0, p1 = toff[ne1] * 256 + nr1;
        const float w0 = nw0 * 0.0625f, w1 = nw1 * 0.0625f;
        { const int tn = t + F.ngw; if (tn < T) { ne0 = rt_e[2 * tn]; ne1 = rt_e[2 * tn + 1]; nr0 = rt_rank[2 * tn]; nr1 = rt_rank[2 * tn + 1]; nw0 = rt_w[2 * tn]; nw1 = rt_w[2 * tn + 1]; } }
        v2u xq[8]; int yq0[8], yq1[8];
#pragma unroll
        for (int j = 0; j < 8; ++j) { const int c = 4 * lane + 256 * j;
            xq[j] = *(const v2u*)(x1b + (size_t)t * D + c); yq0[j] = *(const int*)(Y + (size_t)p0 * D + c); yq1[j] = *(const int*)(Y + (size_t)p1 * D + c); }
        f32x4 v[8]; float s = 0.f; float* xr = outp + (size_t)t * D;
#pragma unroll
        for (int j = 0; j < 8; ++j) { const v2u xb2 = xq[j];
            f32x4 xv; xv.x = __uint_as_float(xb2.x << 16); xv.y = __uint_as_float(xb2.x & 0xffff0000u); xv.z = __uint_as_float(xb2.y << 16); xv.w = __uint_as_float(xb2.y & 0xffff0000u);
            const f32x2_ a0 = __builtin_amdgcn_cvt_pk_f32_fp8(yq0[j], false), a1 = __builtin_amdgcn_cvt_pk_f32_fp8(yq0[j], true);
            const f32x2_ c0 = __builtin_amdgcn_cvt_pk_f32_fp8(yq1[j], false), c1 = __builtin_amdgcn_cvt_pk_f32_fp8(yq1[j], true);
            f32x4 m;
            m.x = w0 * a0.x + w1 * c0.x; m.y = w0 * a0.y + w1 * c0.y; m.z = w0 * a1.x + w1 * c1.x; m.w = w0 * a1.y + w1 * c1.y;
            v[j] = xv * ALPHA + m; s += (v[j].x + v[j].y) + (v[j].z + v[j].w); }
        const float mean = wave_sum(s) * (1.f / D); float s2 = 0.f;
#pragma unroll
        for (int j = 0; j < 8; ++j) { v[j] = v[j] - mean; s2 += (v[j].x * v[j].x + v[j].y * v[j].y) + (v[j].z * v[j].z + v[j].w * v[j].w); }
        const float rstd = 1.f / sqrtf(wave_sum(s2) * (1.f / D) + LN_EPS);
#pragma unroll
        for (int j = 0; j < 8; ++j) { const int c = 4 * lane + 256 * j; *(f32x4*)(xr + c) = v[j] * rstd * gg[j] + bb[j]; }
    }
}


namespace g8 {
typedef short bf16x8 __attribute__((ext_vector_type(8)));
typedef int v8i __attribute__((ext_vector_type(8)));
typedef int v4i __attribute__((ext_vector_type(4)));
constexpr int BM = 256, BK = 64, HALF = 128, HTB = HALF * BK * 2, STAGE_BYTES = 8 * HTB;
__device__ __forceinline__ int lds_byte(int r, int c) { const int st = (r >> 4) * 2 + (c >> 5), rr = r & 15, cc = c & 31, ob = rr * 64 + cc * 2; return st * 1024 + (ob ^ (((ob >> 9) & 1) << 5)); }
__device__ __forceinline__ void stage_rc(int b, int& R, int& C) { const int st = b / 1024, sb = b % 1024, swz = sb ^ (((sb >> 9) & 1) << 5); R = (st >> 1) * 16 + swz / 64; C = (st & 1) * 32 + (swz % 64) / 2; }
__device__ __forceinline__ int perm32(int rho) { const int n = rho >> 4, i = rho & 15; return 8 * (i >> 2) + 4 * n + (i & 3); }
__device__ __forceinline__ unsigned cvt_pk_bf16(float lo, float hi) { unsigned r; asm volatile("v_cvt_pk_bf16_f32 %0, %1, %2" : "=v"(r) : "v"(lo), "v"(hi)); return r; }
struct Unit { int pm, pn, e; };

template <class P, bool SP2 = true>
__device__ __forceinline__ void gemm_phase(LAS unsigned char* lds, const P& prob) {
    const int tid = threadIdx.x, wid = __builtin_amdgcn_readfirstlane(tid >> 6), lane = tid & 63, wr = wid >> 2, wc = wid & 3, fr = lane & 15, fq = lane >> 4;
    constexpr bool F8 = P::FP8;
    constexpr int K = P::K, KB = F8 ? K : 2 * K, nt = KB / 128;
    unsigned voffB[2]; int RA[2]; unsigned CA2[2];
#pragma unroll
    for (int i = 0; i < 2; ++i) { int R, C; stage_rc(tid * 16 + i * 8192, R, C); const int Rb = P::PERM ? ((R & ~31) + perm32(R & 31)) : R;
        RA[i] = R; CA2[i] = (unsigned)C * 2u; voffB[i] = (unsigned)(Rb * KB) + (unsigned)C * 2u; }
    constexpr size_t kstep = (size_t)(BK * 2);
    constexpr size_t hstep = (size_t)HALF * KB;
    const unsigned ldsw = (unsigned)wid * 1024u;
    const int aoff = lds_byte(wr * 64 + fr, F8 ? fq * 16 : fq * 8), boff = lds_byte(wc * 32 + fr, F8 ? fq * 16 : fq * 8);
    constexpr int aoff1 = F8 ? 16 : 1024, boff1 = F8 ? 16 : 1024;
    const char* const Abase = prob.a_base();
#define G8_SA(b, h) (((b) * 2 + (h)) * HTB)
#define G8_SB(b, h) ((4 + (b) * 2 + (h)) * HTB)
#define G8_STAGE_B(bufoff, gbase) do { _Pragma("unroll") for (int _i = 0; _i < 2; ++_i) \
        __builtin_amdgcn_global_load_lds((const unsigned*)((const char*)(gbase) + voffB[_i]), (LAS unsigned*)(lds + (bufoff) + ldsw + _i * 8192), 16, 0, 0); } while (0)
#define G8_STAGE_A(bufoff, kbyte, vo) do { _Pragma("unroll") for (int _i = 0; _i < 2; ++_i) \
        __builtin_amdgcn_global_load_lds((const unsigned*)(Abase + (size_t)(kbyte) + (vo)[_i]), (LAS unsigned*)(lds + (bufoff) + ldsw + _i * 8192), 16, 0, 0); } while (0)
#define G8_LDA(dst, b, h) do { _Pragma("unroll") for (int m = 0; m < 4; ++m) { if constexpr (F8) { const LAS unsigned char* q_ = lds + G8_SA(b, h) + aoff + m * 2048; \
            dst##8[m] = __builtin_shufflevector(*(const LAS v4i*)q_, *(const LAS v4i*)(q_ + aoff1), 0, 1, 2, 3, 4, 5, 6, 7); } \
        else { _Pragma("unroll") for (int k = 0; k < 2; ++k) dst[m][k] = *(const LAS bf16x8*)(lds + G8_SA(b, h) + aoff + m * 2048 + k * aoff1); } } } while (0)
#define G8_LDB(dst, b, h) do { _Pragma("unroll") for (int n = 0; n < 2; ++n) { if constexpr (F8) { const LAS unsigned char* q_ = lds + G8_SB(b, h) + boff + n * 2048; \
            dst##8[n] = __builtin_shufflevector(*(const LAS v4i*)q_, *(const LAS v4i*)(q_ + boff1), 0, 1, 2, 3, 4, 5, 6, 7); } \
        else { _Pragma("unroll") for (int k = 0; k < 2; ++k) dst[n][k] = *(const LAS bf16x8*)(lds + G8_SB(b, h) + boff + n * 2048 + k * boff1); } } } while (0)
#define G8_MMA(ai, bj, At, Bt) do { __builtin_amdgcn_s_setprio(1); _Pragma("unroll") for (int m = 0; m < 4; ++m) _Pragma("unroll") for (int n = 0; n < 2; ++n) { \
        if constexpr (F8) asm volatile("v_mfma_scale_f32_16x16x128_f8f6f4 %0, %1, %2, %0, %3, %4 op_sel_hi:[0,0,0]" : "+v"(acc[ai][bj][m][n]) : "v"(Bt##8[n]), "v"(At##8[m]), "v"(sclB), "v"(sclA)); \
        else { _Pragma("unroll") for (int k = 0; k < 2; ++k) acc[ai][bj][m][n] = __builtin_amdgcn_mfma_f32_16x16x32_bf16(Bt[n][k], At[m][k], acc[ai][bj][m][n], 0, 0, 0); } } \
        __builtin_amdgcn_s_setprio(0); } while (0)
#define G8_WAIT_V(n) asm volatile("s_waitcnt vmcnt(" #n ")" ::: "memory")
#define G8_WAIT_L(n) asm volatile("s_waitcnt lgkmcnt(" #n ")" ::: "memory")
#define G8_BAR __builtin_amdgcn_s_barrier()
#define G8_SCHED __builtin_amdgcn_sched_barrier(0)
    Unit cur, nxt; int ui = 0;
    if (!prob.next(0, cur)) return;
    f32x4 acc[2][2][4][2];
#pragma unroll
    for (int a = 0; a < 2; ++a)
#pragma unroll
        for (int b = 0; b < 2; ++b)
#pragma unroll
            for (int m = 0; m < 4; ++m)
#pragma unroll
                for (int n = 0; n < 2; ++n) acc[a][b][m][n] = (f32x4){0.f, 0.f, 0.f, 0.f};
    bf16x8 At[4][2], B0[2][2], B1[2][2];
    v8i At8[4], B08[2], B18[2];
    const int sclA = P::SCALE_A, sclB = P::SCALE_B;
    unsigned voC[2][2], voN[2][2];
#pragma unroll
    for (int h = 0; h < 2; ++h)
#pragma unroll
        for (int i = 0; i < 2; ++i) voC[h][i] = prob.a_off(cur, h * HALF + RA[i]) + CA2[i];
    const char* cB = prob.b_tile(cur);
    if constexpr (SP2) {
    G8_STAGE_B(G8_SB(0, 0), cB); G8_STAGE_B(G8_SB(0, 1), cB + hstep); G8_STAGE_A(G8_SA(0, 0), 0, voC[0]); G8_STAGE_A(G8_SA(0, 1), 0, voC[1]);
    if (wr == 1) G8_BAR;
    G8_WAIT_V(2); G8_BAR;
    G8_STAGE_B(G8_SB(1, 0), cB + kstep); G8_STAGE_A(G8_SA(1, 0), kstep, voC[0]); G8_STAGE_B(G8_SB(1, 1), cB + hstep + kstep);
    G8_WAIT_V(6); G8_BAR;
    } else {
    G8_STAGE_B(G8_SB(0, 0), cB); G8_STAGE_A(G8_SA(0, 0), 0, voC[0]); G8_STAGE_B(G8_SB(0, 1), cB + hstep); G8_STAGE_A(G8_SA(0, 1), 0, voC[1]);
    if (wr == 1) G8_BAR;
    G8_WAIT_V(4); G8_BAR;
    G8_STAGE_B(G8_SB(1, 0), cB + kstep); G8_STAGE_A(G8_SA(1, 0), kstep, voC[0]); G8_STAGE_B(G8_SB(1, 1), cB + hstep + kstep);
    G8_WAIT_V(6); G8_BAR;
    }
    for (;;) {
        const bool has_next = prob.next(ui + 1, nxt);
        const char* nB = cB;
        if (has_next) {
            nB = prob.b_tile(nxt);
#pragma unroll
            for (int h = 0; h < 2; ++h)
#pragma unroll
                for (int i = 0; i < 2; ++i) voN[h][i] = prob.a_off(nxt, h * HALF + RA[i]) + CA2[i];
        } else {
#pragma unroll
            for (int h = 0; h < 2; ++h)
#pragma unroll
                for (int i = 0; i < 2; ++i) voN[h][i] = voC[h][i];
        }
        for (int t = 0; t < nt; t += 2) {
            const bool last = (t == nt - 2);
            const size_t k1 = (size_t)(t + 1) * kstep;
            const size_t k2 = last ? 0 : (size_t)(t + 2) * kstep, k3 = k2 + kstep;
            const char* b2 = last ? nB : cB + (size_t)(t + 2) * kstep; const char* b3 = b2 + kstep;
            unsigned vo2[2][2];
#pragma unroll
            for (int h = 0; h < 2; ++h)
#pragma unroll
                for (int i = 0; i < 2; ++i) vo2[h][i] = last ? voN[h][i] : voC[h][i];
            if constexpr (SP2) {
            G8_LDB(B0, 0, 0); G8_LDB(B1, 0, 1); G8_SCHED; G8_LDA(At, 0, 0); G8_STAGE_A(G8_SA(1, 1), k1, voC[1]);
            G8_WAIT_V(8); G8_WAIT_L(0); G8_BAR; G8_MMA(0, 0, At, B0); G8_MMA(0, 1, At, B1); G8_BAR; G8_SCHED;
            G8_LDA(At, 0, 1); G8_STAGE_B(G8_SB(0, 0), b2); G8_STAGE_B(G8_SB(0, 1), b2 + hstep); G8_STAGE_A(G8_SA(0, 0), k2, vo2[0]);
            G8_WAIT_V(8); G8_WAIT_L(0); G8_BAR; G8_MMA(1, 0, At, B0); G8_MMA(1, 1, At, B1); G8_BAR; G8_SCHED;
            G8_LDB(B0, 1, 0); G8_LDB(B1, 1, 1); G8_SCHED; G8_LDA(At, 1, 0); G8_STAGE_A(G8_SA(0, 1), k2, vo2[1]);
            G8_WAIT_V(8); G8_WAIT_L(0); G8_BAR; G8_MMA(0, 0, At, B0); G8_MMA(0, 1, At, B1); G8_BAR; G8_SCHED;
            G8_LDA(At, 1, 1); G8_STAGE_B(G8_SB(1, 0), b3); G8_STAGE_B(G8_SB(1, 1), b3 + hstep); G8_STAGE_A(G8_SA(1, 0), k3, vo2[0]);
            G8_WAIT_V(8); G8_WAIT_L(0); G8_BAR; G8_MMA(1, 0, At, B0); G8_MMA(1, 1, At, B1); G8_BAR; G8_SCHED;
            } else {
            G8_LDB(B0, 0, 0); G8_SCHED; G8_LDA(At, 0, 0); G8_STAGE_A(G8_SA(1, 1), k1, voC[1]);
            G8_WAIT_L(8); G8_BAR; G8_WAIT_L(0); G8_MMA(0, 0, At, B0); G8_BAR; G8_SCHED;
            G8_LDB(B1, 0, 1); G8_STAGE_B(G8_SB(0, 0), b2);
            G8_BAR; G8_WAIT_L(0); G8_MMA(0, 1, At, B1); G8_BAR;
            G8_LDA(At, 0, 1); G8_STAGE_A(G8_SA(0, 0), k2, vo2[0]);
            G8_BAR; G8_WAIT_L(0); G8_MMA(1, 0, At, B0); G8_BAR; G8_SCHED;
            G8_STAGE_B(G8_SB(0, 1), b2 + hstep);
            G8_WAIT_V(6); G8_BAR; G8_MMA(1, 1, At, B1); G8_BAR;
            G8_LDB(B0, 1, 0); G8_SCHED; G8_LDA(At, 1, 0); G8_STAGE_A(G8_SA(0, 1), k2, vo2[1]);
            G8_WAIT_L(8); G8_BAR; G8_WAIT_L(0); G8_MMA(0, 0, At, B0); G8_BAR; G8_SCHED;
            G8_LDB(B1, 1, 1); G8_STAGE_B(G8_SB(1, 0), b3);
            G8_BAR; G8_WAIT_L(0); G8_MMA(0, 1, At, B1); G8_BAR;
            G8_LDA(At, 1, 1); G8_STAGE_A(G8_SA(1, 0), k3, vo2[0]);
            G8_BAR; G8_WAIT_L(0); G8_MMA(1, 0, At, B0); G8_BAR; G8_SCHED;
            G8_STAGE_B(G8_SB(1, 1), b3 + hstep);
            G8_WAIT_V(6); G8_BAR; G8_MMA(1, 1, At, B1); G8_BAR;
            }
        }
        if (wr == 0) G8_BAR;
        prob.epi(acc, cur, wr, wc, fr, fq);
        prob.done(cur);
        if (!has_next) break;
#pragma unroll
        for (int a = 0; a < 2; ++a)
#pragma unroll
            for (int b = 0; b < 2; ++b)
#pragma unroll
                for (int m = 0; m < 4; ++m)
#pragma unroll
                    for (int n = 0; n < 2; ++n) acc[a][b][m][n] = (f32x4){0.f, 0.f, 0.f, 0.f};
        cur = nxt; cB = nB; ++ui;
#pragma unroll
        for (int h = 0; h < 2; ++h)
#pragma unroll
            for (int i = 0; i < 2; ++i) voC[h][i] = voN[h][i];
        if (wr == 1) G8_BAR;
    }
    G8_WAIT_V(0);
    G8_BAR;
#undef G8_SA
#undef G8_SB
#undef G8_STAGE_A
#undef G8_STAGE_B
#undef G8_LDA
#undef G8_LDB
#undef G8_MMA
#undef G8_WAIT_V
#undef G8_WAIT_L
#undef G8_BAR
#undef G8_SCHED
}

struct DenseOrder {
    int nM, nN, nwg, G, c, i0, i1;
    __device__ __forceinline__ void init(int M, int N, int G_, int c_) { nM = M / BM; nN = N / BM; nwg = nM * nN; G = G_; c = c_; i0 = 0; i1 = 1 << 30; }
    __device__ __forceinline__ bool next(int i, Unit& u) const {
        if (i + i0 >= i1) return false;
        const long L = (long)(i + i0) * G + c; if (L >= nwg) return false;
        int wgid = (int)L; { const int q = nwg / 8, r = nwg % 8, xcd = wgid % 8, off = wgid / 8; wgid = (xcd < r ? xcd * (q + 1) : r * (q + 1) + (xcd - r) * q) + off; }
        const int nig = 8 * nN, gid = wgid / nig, fm = gid * 8, gsz = (nM - fm) < 8 ? (nM - fm) : 8;
        u.pm = fm + ((wgid % nig) % gsz); u.pn = (wgid % nig) / gsz; u.e = 0; return true;
    }
};

struct ProbProj {
    static constexpr int K = D; static constexpr bool PERM = true, FP8 = false; static constexpr int SCALE_A = 0, SCALE_B = 0;
    const char* A; const char* Bt; bf16_t* C; DenseOrder ord;
    __device__ __forceinline__ bool next(int i, Unit& u) const { return ord.next(i, u); }
    __device__ __forceinline__ void done(const Unit&) const {}
    __device__ __forceinline__ const char* a_base() const { return A; }
    __device__ __forceinline__ unsigned a_off(const Unit& u, int r) const { return (unsigned)(u.pm * BM + r) * (unsigned)(K * 2); }
    __device__ __forceinline__ const char* b_tile(const Unit& u) const { return Bt + (size_t)u.pn * BM * K * 2; }
    __device__ __forceinline__ void epi(const f32x4 (&acc)[2][2][4][2], const Unit& u, int wr, int wc, int fr, int fq) const {
        const int row0 = u.pm * BM + wr * 64 + fr, col0 = u.pn * BM + wc * 32 + 8 * fq;
#pragma unroll
        for (int ai = 0; ai < 2; ++ai)
#pragma unroll
            for (int m = 0; m < 4; ++m) { bf16_t* rowp = C + (size_t)(row0 + ai * HALF + m * 16) * DP + col0;
#pragma unroll
                for (int bj = 0; bj < 2; ++bj) { const f32x4 v0 = acc[ai][bj][m][0], v1 = acc[ai][bj][m][1];
                    v4u w; w.x = cvt_pk_bf16(v0[0], v0[1]); w.y = cvt_pk_bf16(v0[2], v0[3]); w.z = cvt_pk_bf16(v1[0], v1[1]); w.w = cvt_pk_bf16(v1[2], v1[3]);
                    *(v4u*)(rowp + bj * HALF) = w; } }
    }
};
struct ProbOut {
    static constexpr int K = D; static constexpr bool PERM = true, FP8 = false; static constexpr int SCALE_A = 0, SCALE_B = 0;
    const char* A; const char* Bt; bf16_t* C; DenseOrder ord;
    __device__ __forceinline__ bool next(int i, Unit& u) const { return ord.next(i, u); }
    __device__ __forceinline__ void done(const Unit&) const {}
    __device__ __forceinline__ const char* a_base() const { return A; }
    __device__ __forceinline__ unsigned a_off(const Unit& u, int r) const { return (unsigned)(u.pm * BM + r) * (unsigned)(K * 2); }
    __device__ __forceinline__ const char* b_tile(const Unit& u) const { return Bt + (size_t)u.pn * BM * K * 2; }
    __device__ __forceinline__ void epi(const f32x4 (&acc)[2][2][4][2], const Unit& u, int wr, int wc, int fr, int fq) const {
        const int row0 = u.pm * BM + wr * 64 + fr, col0 = u.pn * BM + wc * 32 + 8 * fq;
#pragma unroll
        for (int ai = 0; ai < 2; ++ai)
#pragma unroll
            for (int m = 0; m < 4; ++m) { bf16_t* rowp = C + (size_t)(row0 + ai * HALF + m * 16) * D + col0;
#pragma unroll
                for (int bj = 0; bj < 2; ++bj) { const f32x4 v0 = acc[ai][bj][m][0], v1 = acc[ai][bj][m][1];
                    v4u w; w.x = cvt_pk_bf16(v0[0], v0[1]); w.y = cvt_pk_bf16(v0[2], v0[3]); w.z = cvt_pk_bf16(v1[0], v1[1]); w.w = cvt_pk_bf16(v1[2], v1[3]);
                    *(v4u*)(rowp + bj * HALF) = w; } }
    }
};
struct MoeQueue {
    const LAS int* toff;
    LAS int* slots;
    unsigned* qhead; unsigned* ready; unsigned* tmo;
    template <bool DOWN>
    __device__ __forceinline__ bool claim(int i, Unit& u) const {
        const int NT = toff[NE], U = 4 * NT, DN = 8 * NT;
        if (threadIdx.x == 0) {
            int d; bool polled = false;
            if (DOWN && i == 0) d = slots[2];
            else if (DOWN && slots[3] >= 0) { d = slots[3]; slots[3] = -1; polled = (((d - U) & 7) != 0); }
            else if (!DOWN && i == 0) d = (int)blockIdx.x;
            else { d = (int)gridDim.x + (int)__hip_atomic_fetch_add(qhead, DOWN ? 2u : 1u, __ATOMIC_RELAXED, __HIP_MEMORY_SCOPE_AGENT); if (DOWN) slots[3] = d + 1; }
            if (!DOWN && d >= U) slots[2] = d;
            if (DOWN && d < U + DN && !polled) {
                const int rt = (d - U) >> 3; unsigned sp = 0;
                while (__hip_atomic_load(ready + 64 * rt, __ATOMIC_RELAXED, __HIP_MEMORY_SCOPE_AGENT) < 32u) {
                    __builtin_amdgcn_s_sleep(2);
                    if ((++sp & 255u) == 0u) { if (__hip_atomic_load(tmo, __ATOMIC_RELAXED, __HIP_MEMORY_SCOPE_AGENT)) break; if (sp > (1u << 20)) { atomicAdd(tmo, 1u); break; } } }
                __builtin_amdgcn_fence(__ATOMIC_ACQUIRE, "agent");
                asm volatile("s_waitcnt vmcnt(0)" ::: "memory");
            }
            slots[i & 1] = d;
        }
        asm volatile("s_waitcnt lgkmcnt(0)" ::: "memory"); __builtin_amdgcn_s_barrier(); asm volatile("" ::: "memory");
        const int d = __builtin_amdgcn_readfirstlane(slots[i & 1]);
        if (!DOWN) { if (d >= U) return false; u.pm = d >> 2; u.pn = d & 3; }
        else { if (d >= U + DN) return false; u.pm = (d - U) >> 3; u.pn = (d - U) & 7; }
        const int ln_ = (int)threadIdx.x & 63, myoff = (ln_ < NE) ? toff[ln_] : 0x7fffffff;
        const unsigned long long mk = __builtin_amdgcn_ballot_w64(u.pm >= myoff);
        u.e = __builtin_amdgcn_readfirstlane(63 - (int)__builtin_clzll(mk)); return true;
    }
};
__device__ __forceinline__ void store8_sc1(void* p, v2u v) { asm volatile("global_store_dwordx2 %0, %1, off sc1\n\ts_nop 1" :: "v"(p), "v"(v) : "memory"); }
__device__ __forceinline__ void store16_sc1(void* p, v4u v) { asm volatile("global_store_dwordx4 %0, %1, off sc1\n\ts_nop 1" :: "v"(p), "v"(v) : "memory"); }
struct ProbUp {
    static constexpr int K = D; static constexpr bool PERM = true, FP8 = true;
    static constexpr int SCALE_A = 0x7f7f7f7f, SCALE_B = 0x79797979;
    const char* A; const char* Bt; unsigned char* H; const int* rowtok; MoeQueue q;
    __device__ __forceinline__ bool next(int i, Unit& u) const { return q.claim<false>(i, u); }
    __device__ __forceinline__ void done(const Unit& u) const {
        asm volatile("s_waitcnt vmcnt(0)" ::: "memory");
        if ((threadIdx.x & 63) == 0) __hip_atomic_fetch_add(q.ready + 64 * u.pm, 1u, __ATOMIC_RELAXED, __HIP_MEMORY_SCOPE_AGENT);
    }
    __device__ __forceinline__ const char* a_base() const { return A; }
    __device__ __forceinline__ unsigned a_off(const Unit& u, int r) const { const int rank = (u.pm - q.toff[u.e]) * BM + r; const int tok = (rank < q.toff[64 + u.e]) ? rowtok[u.e * 16384 + rank] : 0; return (unsigned)tok * (unsigned)K; }
    __device__ __forceinline__ const char* b_tile(const Unit& u) const { return Bt + ((size_t)u.e * 1024 + (size_t)u.pn * BM) * K; }
    __device__ __forceinline__ void epi(const f32x4 (&acc)[2][2][4][2], const Unit& u, int wr, int wc, int fr, int fq) const {
        const int row0 = u.pm * BM + wr * 64 + fr, col0 = u.pn * HALF + wc * 32 + 8 * fq;
#pragma unroll
        for (int ai = 0; ai < 2; ++ai)
#pragma unroll
            for (int m = 0; m < 4; ++m) { unsigned char* rowp = H + (size_t)(row0 + ai * HALF + m * 16) * DE + col0;
                float hv[8];
#pragma unroll
                for (int n = 0; n < 2; ++n)
#pragma unroll
                    for (int j = 0; j < 4; ++j) { const float g = acc[ai][0][m][n][j], v = acc[ai][1][m][n][j]; hv[n * 4 + j] = g * __builtin_amdgcn_rcpf(1.f + __expf(-g)) * v; }
                int p0 = 0, p1 = 0;
                p0 = __builtin_amdgcn_cvt_pk_fp8_f32(hv[0], hv[1], p0, false); p0 = __builtin_amdgcn_cvt_pk_fp8_f32(hv[2], hv[3], p0, true);
                p1 = __builtin_amdgcn_cvt_pk_fp8_f32(hv[4], hv[5], p1, false); p1 = __builtin_amdgcn_cvt_pk_fp8_f32(hv[6], hv[7], p1, true);
                store8_sc1(rowp, (v2u){(unsigned)p0, (unsigned)p1}); }
    }
};
struct ProbDown {
    static constexpr int K = DE; static constexpr bool PERM = true, FP8 = true;
    static constexpr int SCALE_A = 0x7f7f7f7f, SCALE_B = 0x7d7d7d7d;
    const char* A; const char* Bt; unsigned char* Y; MoeQueue q;
    __device__ __forceinline__ bool next(int i, Unit& u) const { return q.claim<true>(i, u); }
    __device__ __forceinline__ void done(const Unit&) const {}
    __device__ __forceinline__ const char* a_base() const { return A; }
    __device__ __forceinline__ unsigned a_off(const Unit& u, int r) const { return (unsigned)(u.pm * BM + r) * (unsigned)K; }
    __device__ __forceinline__ const char* b_tile(const Unit& u) const { return Bt + ((size_t)u.e * D + (size_t)u.pn * BM) * K; }
    __device__ __forceinline__ void epi(const f32x4 (&acc)[2][2][4][2], const Unit& u, int wr, int wc, int fr, int fq) const {
        const int row0 = u.pm * BM + wr * 64 + fr, col0 = u.pn * BM + wc * 32 + 8 * fq;
#pragma unroll
        for (int ai = 0; ai < 2; ++ai)
#pragma unroll
            for (int m = 0; m < 4; ++m) { unsigned char* rowp = Y + (size_t)(row0 + ai * HALF + m * 16) * D + col0;
#pragma unroll
                for (int bj = 0; bj < 2; ++bj) { const f32x4 v0 = acc[ai][bj][m][0], v1 = acc[ai][bj][m][1];
                    int p0 = 0, p1 = 0;
                    p0 = __builtin_amdgcn_cvt_pk_fp8_f32(v0[0], v0[1], p0, false); p0 = __builtin_amdgcn_cvt_pk_fp8_f32(v0[2], v0[3], p0, true);
                    p1 = __builtin_amdgcn_cvt_pk_fp8_f32(v1[0], v1[1], p1, false); p1 = __builtin_amdgcn_cvt_pk_fp8_f32(v1[2], v1[3], p1, true);
                    v2u w; w.x = (unsigned)p0; w.y = (unsigned)p1;
                    *(v2u*)(rowp + bj * HALF) = w; } }
    }
};
}


namespace att {
typedef short bf16x8 __attribute__((ext_vector_type(8)));
typedef short s16x4 __attribute__((ext_vector_type(4)));
constexpr int NUNITS = 3 * NBATCH * NH * 32;
constexpr float LOG2E = 1.4426950408889634f, LN2 = 0.6931471805599453f;
__device__ __forceinline__ s16x4 vtr(const LAS unsigned char* p) { return __builtin_bit_cast(s16x4, __builtin_amdgcn_ds_read_tr16_b64_v4i16((LAS s16x4*)p)); }
__device__ __forceinline__ unsigned cvt_pk_bf16(float lo, float hi) { unsigned r; asm volatile("v_cvt_pk_bf16_f32 %0, %1, %2" : "=v"(r) : "v"(lo), "v"(hi)); return r; }

struct UnitA { int p, b, h, r, n, dil; };
__device__ __forceinline__ UnitA decode(int u) {
    UnitA x; x.p = u >> 11; const int rem = u & 2047; x.b = rem >> 9; x.h = (rem >> 5) & 15; const int j = rem & 31;
    x.dil = 1 << (2 * x.p); const int nblk = 32 >> (2 * x.p); x.r = j / nblk; x.n = j % nblk; return x;
}

__device__ __forceinline__ void attn_phase(const Frame& F, const Args& a) {
    const bf16_t* proj = (const bf16_t*)(a.ws + WS_B);
    const int tid = F.tid, lane = F.lane, w = F.wave, i = lane & 15, g = lane >> 4;
    const bool xo = (gridDim.x == 256);
    const int per = xo ? 24 : (NUNITS + (int)gridDim.x - 1) / (int)gridDim.x;
    const int u0 = xo ? 0 : (int)blockIdx.x * per, u1 = xo ? 24 : ((u0 + per < NUNITS) ? (u0 + per) : NUNITS);
    if (u0 >= u1) return;
    const int xcd_ = (int)blockIdx.x & 7, rank_ = (int)blockIdx.x >> 3;
#define ATT_UNIT(k) (xo ? ({ const int s_ = (k) / 3, ul_ = rank_ * 3 + ((k) - 3 * s_), pair_ = xcd_ * 8 + s_; ((ul_ >> 5) << 11) + ((pair_ >> 4) << 9) + ((pair_ & 15) << 5) + (ul_ & 31); }) : (k))
    v4u kst[4], vst[4], qst[2];
    const unsigned kvo0 = (unsigned)(tid >> 3) * (unsigned)(DP * 2), kvo1 = (unsigned)(tid & 7) * 16u;
    const unsigned qvo0 = (unsigned)(16 * w + i) * (unsigned)(DP * 2), qvo1 = (unsigned)g * 16u;
#define ATT_LOADK(U) do { const UnitA x_ = decode(U); const int sh_ = 2 * x_.p; \
        const char* kb_ = (const char*)proj + ((long)x_.b * SEQ + (long)(128 * (x_.n - 1)) * x_.dil + x_.r) * (long)(DP * 2) + (long)((DA + x_.h * HD) * 2); \
        const unsigned vo_ = (kvo0 << sh_) + kvo1; \
        _Pragma("unroll") for (int jj = 0; jj < 4; ++jj) { \
            if (x_.n > 0 || jj >= 2) { const char* kp = kb_ + ((size_t)(64 * jj) * (size_t)(DP * 2) << sh_); kst[jj] = *(const v4u*)(kp + vo_); } \
            else kst[jj] = (v4u){0u, 0u, 0u, 0u}; } \
        { const char* qb_ = (const char*)proj + ((long)x_.b * SEQ + (long)(128 * x_.n) * x_.dil + x_.r) * (long)(DP * 2) + (long)(x_.h * HD * 2); const unsigned qo_ = (qvo0 << sh_) + qvo1; \
          qst[0] = *(const v4u*)(qb_ + qo_); qst[1] = *(const v4u*)(qb_ + qo_ + 64); } } while (0)
#define ATT_LOADV(U) do { const UnitA x_ = decode(U); const int sh_ = 2 * x_.p; \
        const char* kb_ = (const char*)proj + ((long)x_.b * SEQ + (long)(128 * (x_.n - 1)) * x_.dil + x_.r) * (long)(DP * 2) + (long)((DA + x_.h * HD) * 2); \
        const unsigned vo_ = (kvo0 << sh_) + kvo1; \
        _Pragma("unroll") for (int jj = 0; jj < 4; ++jj) { \
            if (x_.n > 0 || jj >= 2) { const char* kp = kb_ + ((size_t)(64 * jj) * (size_t)(DP * 2) << sh_); vst[jj] = *(const v4u*)(kp + vo_ + DA * 2); } \
            else vst[jj] = (v4u){0u, 0u, 0u, 0u}; } } while (0)
    ATT_LOADK(ATT_UNIT(u0));
    const int kaddr0 = (16 * w + i) * 128 + (((g) ^ (i & 7)) << 4), kaddr1 = (16 * w + i) * 128 + (((g + 4) ^ (i & 7)) << 4);
    int vaddr[4];
    { const int q = i >> 2, p_ = i & 3, key = 16 * w + 4 * g + q, k7 = key & 7;
#pragma unroll
      for (int dt = 0; dt < 4; ++dt) vaddr[dt] = key * 128 + (((2 * dt + (p_ >> 1)) ^ k7) << 4) + (p_ & 1) * 8; }
    bool mlo[4], mhi[4];
#pragma unroll
    for (int j = 0; j < 4; ++j) { mlo[j] = (4 * g + j >= i); mhi[j] = (4 * g + j <= i); }
    typedef float f32x2 __attribute__((ext_vector_type(2)));
    bf16x8 qf[2];
    f32x4 Sp[9], Sc[9];
    float m = 0.f; f32x2 l01 = (f32x2){0.f, 0.f}, l23 = l01; f32x2 mm = l01;
#define ATT_STAGEK(U_) do { LAS unsigned char* Kw_ = F.lds + (((U_) - u0) & 1) * 65536; \
        _Pragma("unroll") for (int jj = 0; jj < 4; ++jj) { const int cidx = tid + 512 * jj, key = cidx >> 3, ch = cidx & 7; const int la = key * 128 + ((ch ^ (key & 7)) << 4); *(LAS v4u*)(Kw_ + la) = kst[jj]; } \
        qf[0] = __builtin_bit_cast(bf16x8, qst[0]); qf[1] = __builtin_bit_cast(bf16x8, qst[1]); } while (0)
#define ATT_STAGEV(U_) do { LAS unsigned char* Vw_ = F.lds + (((U_) - u0) & 1) * 65536 + 32768; \
        _Pragma("unroll") for (int jj = 0; jj < 4; ++jj) { const int cidx = tid + 512 * jj, key = cidx >> 3, ch = cidx & 7; const int la = key * 128 + ((ch ^ (key & 7)) << 4); *(LAS v4u*)(Vw_ + la) = vst[jj]; } } while (0)
#define ATT_INIT(S_, x_) do { const float slope = exp2f(-0.5f * (float)((x_).h + 1)); const float c2 = slope * (float)(x_).dil * LOG2E, c16 = 16.f * c2; \
        const float nb = -c2 * (float)(128 + i - 4 * g); f32x2 r01, r23; r01.x = nb; r01.y = nb + c2; r23.x = fmaf(2.f, c2, nb); r23.y = fmaf(3.f, c2, nb); const f32x2 cc = (f32x2){c16, c16}; \
        S_[0][0] = mlo[0] ? r01.x : -INFINITY; S_[0][1] = mlo[1] ? r01.y : -INFINITY; S_[0][2] = mlo[2] ? r23.x : -INFINITY; S_[0][3] = mlo[3] ? r23.y : -INFINITY; \
        _Pragma("unroll") for (int Tt = 1; Tt < 8; ++Tt) { r01 += cc; r23 += cc; S_[Tt][0] = r01.x; S_[Tt][1] = r01.y; S_[Tt][2] = r23.x; S_[Tt][3] = r23.y; } \
        r01 += cc; r23 += cc; \
        S_[8][0] = mhi[0] ? r01.x : -INFINITY; S_[8][1] = mhi[1] ? r01.y : -INFINITY; S_[8][2] = mhi[2] ? r23.x : -INFINITY; S_[8][3] = mhi[3] ? r23.y : -INFINITY; \
        if ((x_).n == 0) { _Pragma("unroll") for (int Tt = 0; Tt < 8; ++Tt) if (Tt < 8 - w) S_[Tt] = (f32x4){-INFINITY, -INFINITY, -INFINITY, -INFINITY}; } } while (0)
#define ATT_LDK(dst, Tt) do { dst[0][0] = *(const LAS bf16x8*)(Kl + kaddr0 + (Tt) * 2048); dst[0][1] = *(const LAS bf16x8*)(Kl + kaddr1 + (Tt) * 2048); \
                              dst[1][0] = *(const LAS bf16x8*)(Kl + kaddr0 + ((Tt) + 1) * 2048); dst[1][1] = *(const LAS bf16x8*)(Kl + kaddr1 + ((Tt) + 1) * 2048); } while (0)
#define ATT_QK(S_, src, Tt) do { f32x4 z0 = S_[Tt], z1 = S_[(Tt) + 1]; \
            z0 = __builtin_amdgcn_mfma_f32_16x16x32_bf16(src[0][0], qf[0], z0, 0, 0, 0); z1 = __builtin_amdgcn_mfma_f32_16x16x32_bf16(src[1][0], qf[0], z1, 0, 0, 0); \
            S_[Tt] = __builtin_amdgcn_mfma_f32_16x16x32_bf16(src[0][1], qf[1], z0, 0, 0, 0); S_[(Tt) + 1] = __builtin_amdgcn_mfma_f32_16x16x32_bf16(src[1][1], qf[1], z1, 0, 0, 0); } while (0)
#define ATT_QK8(S_) do { f32x4 z0 = __builtin_amdgcn_mfma_f32_16x16x32_bf16(ka[0][0], qf[0], S_[8], 0, 0, 0); S_[8] = __builtin_amdgcn_mfma_f32_16x16x32_bf16(ka[0][1], qf[1], z0, 0, 0, 0); } while (0)
#define ATT_MAX(S_) do { float m4[4]; \
        _Pragma("unroll") for (int j = 0; j < 4; ++j) { float t = fmaxf(fmaxf(S_[0][j], S_[1][j]), S_[2][j]); t = fmaxf(fmaxf(t, S_[3][j]), S_[4][j]); t = fmaxf(fmaxf(t, S_[5][j]), S_[6][j]); m4[j] = fmaxf(fmaxf(t, S_[7][j]), S_[8][j]); } \
        m = fmaxf(fmaxf(m4[0], m4[1]), fmaxf(m4[2], m4[3])); m = fmaxf(m, __shfl_xor(m, 16)); m = fmaxf(m, __shfl_xor(m, 32)); mm = (f32x2){m, m}; l01 = (f32x2){0.f, 0.f}; l23 = l01; } while (0)
#define ATT_EXP1(S_, Tt) do { const f32x2 d01 = (f32x2){S_[Tt][0], S_[Tt][1]} - mm, d23 = (f32x2){S_[Tt][2], S_[Tt][3]} - mm; \
        f32x2 p01, p23; p01.x = __builtin_amdgcn_exp2f(d01.x); p01.y = __builtin_amdgcn_exp2f(d01.y); p23.x = __builtin_amdgcn_exp2f(d23.x); p23.y = __builtin_amdgcn_exp2f(d23.y); \
        S_[Tt][0] = p01.x; S_[Tt][1] = p01.y; S_[Tt][2] = p23.x; S_[Tt][3] = p23.y; l01 += p01; l23 += p23; } while (0)
#define ATT_LDV(dst, c) do { _Pragma("unroll") for (int dt = 0; dt < 4; ++dt) { dst[dt][0] = vtr(Vl + vaddr[dt] + (c) * 4096); dst[dt][1] = vtr(Vl + vaddr[dt] + (c) * 4096 + 2048); } } while (0)
#define ATT_PV(S_, src, c) do { v4u pw; pw.x = cvt_pk_bf16(S_[2 * (c)][0], S_[2 * (c)][1]); pw.y = cvt_pk_bf16(S_[2 * (c)][2], S_[2 * (c)][3]); \
            pw.z = cvt_pk_bf16(S_[2 * (c) + 1][0], S_[2 * (c) + 1][1]); pw.w = cvt_pk_bf16(S_[2 * (c) + 1][2], S_[2 * (c) + 1][3]); const bf16x8 pf = __builtin_bit_cast(bf16x8, pw); \
            _Pragma("unroll") for (int dt = 0; dt < 4; ++dt) { const v2u lo_ = __builtin_bit_cast(v2u, src[dt][0]), hi_ = __builtin_bit_cast(v2u, src[dt][1]); const bf16x8 vf = __builtin_bit_cast(bf16x8, ((v4u){lo_.x, lo_.y, hi_.x, hi_.y})); \
                O[dt] = __builtin_amdgcn_mfma_f32_16x16x32_bf16(vf, pf, O[dt], 0, 0, 0); } } while (0)
#define ATT_FINISH(S_, x_) do { float l = (l01.x + l01.y) + (l23.x + l23.y); l += __shfl_xor(l, 16); l += __shfl_xor(l, 32); \
        f32x4 O[4]; _Pragma("unroll") for (int dt = 0; dt < 4; ++dt) O[dt] = (f32x4){0.f, 0.f, 0.f, 0.f}; \
        { s16x4 va[4][2], vb[4][2], vt[4]; \
            ATT_LDV(va, 0); ATT_LDV(vb, 1); __builtin_amdgcn_sched_barrier(0); \
            ATT_PV(S_, va, 0); __builtin_amdgcn_sched_barrier(0); ATT_LDV(va, 2); __builtin_amdgcn_sched_barrier(0); \
            ATT_PV(S_, vb, 1); __builtin_amdgcn_sched_barrier(0); ATT_LDV(vb, 3); \
            _Pragma("unroll") for (int dt = 0; dt < 4; ++dt) vt[dt] = vtr(Vl + vaddr[dt] + 16384); \
            __builtin_amdgcn_sched_barrier(0); \
            ATT_PV(S_, va, 2); __builtin_amdgcn_sched_barrier(0); \
            ATT_PV(S_, vb, 3); __builtin_amdgcn_sched_barrier(0); \
            { v4u pw; pw.x = cvt_pk_bf16(S_[8][0], S_[8][1]); pw.y = cvt_pk_bf16(S_[8][2], S_[8][3]); pw.z = 0u; pw.w = 0u; const bf16x8 pf = __builtin_bit_cast(bf16x8, pw); \
              _Pragma("unroll") for (int dt = 0; dt < 4; ++dt) { const v2u lo_ = __builtin_bit_cast(v2u, vt[dt]); const bf16x8 vf = __builtin_bit_cast(bf16x8, ((v4u){lo_.x, lo_.y, lo_.x, lo_.y})); \
                O[dt] = __builtin_amdgcn_mfma_f32_16x16x32_bf16(vf, pf, O[dt], 0, 0, 0); } } \
            __builtin_amdgcn_sched_barrier(0); } \
        const float inv = __builtin_amdgcn_rcpf(l); \
        const size_t tq = (size_t)(x_).b * SEQ + (size_t)(128 * (x_).n + 16 * w + i) * (x_).dil + (x_).r; \
        bf16_t* op = (bf16_t*)((unsigned char*)a.out + DO_O + (size_t)(x_).p * DO_OSTRIDE) + tq * DA + (x_).h * HD + 4 * g; \
        _Pragma("unroll") for (int dt = 0; dt < 4; ++dt) { v2u o; o.x = cvt_pk_bf16(O[dt][0] * inv, O[dt][1] * inv); o.y = cvt_pk_bf16(O[dt][2] * inv, O[dt][3] * inv); *(v2u*)(op + 16 * dt) = o; } \
        if (g == 0) ((float*)(a.ws + WS_LSE))[((size_t)(x_).p * T + tq) * NH + (x_).h] = (m + __builtin_amdgcn_logf(l)) * LN2; } while (0)
    __syncthreads();
    ATT_STAGEK(u0);
    __syncthreads();
    {
        if (u0 + 1 < u1) ATT_LOADK(ATT_UNIT(u0 + 1));
        ATT_LOADV(ATT_UNIT(u0));
        const UnitA x = decode(ATT_UNIT(u0));
        const LAS unsigned char* Kl = F.lds;
        ATT_INIT(Sp, x);
        bf16x8 ka[2][2], kb[2][2];
        ATT_LDK(ka, 0); ATT_LDK(kb, 2); __builtin_amdgcn_sched_barrier(0);
        ATT_QK(Sp, ka, 0); __builtin_amdgcn_sched_barrier(0); ATT_LDK(ka, 4); __builtin_amdgcn_sched_barrier(0);
        ATT_QK(Sp, kb, 2); __builtin_amdgcn_sched_barrier(0); ATT_LDK(kb, 6); __builtin_amdgcn_sched_barrier(0);
        ATT_QK(Sp, ka, 4); __builtin_amdgcn_sched_barrier(0);
        ka[0][0] = *(const LAS bf16x8*)(Kl + kaddr0 + 8 * 2048); ka[0][1] = *(const LAS bf16x8*)(Kl + kaddr1 + 8 * 2048); __builtin_amdgcn_sched_barrier(0);
        ATT_QK(Sp, kb, 6); __builtin_amdgcn_sched_barrier(0);
        ATT_QK8(Sp); __builtin_amdgcn_sched_barrier(0);
        if (u0 + 1 < u1) ATT_STAGEK(u0 + 1);
        ATT_STAGEV(u0);
        __syncthreads();
    }
    for (int u = u0 + 1; u < u1; ++u) {
        if (u + 1 < u1) ATT_LOADK(ATT_UNIT(u + 1));
        ATT_LOADV(ATT_UNIT(u));
        const UnitA x = decode(ATT_UNIT(u)), xp = decode(ATT_UNIT(u - 1));
        const LAS unsigned char* Kl = F.lds + ((u - u0) & 1) * 65536; const LAS unsigned char* Vl = F.lds + ((u - 1 - u0) & 1) * 65536 + 32768;
        ATT_MAX(Sp);
        ATT_INIT(Sc, x);
        bf16x8 ka[2][2], kb[2][2];
        ATT_LDK(ka, 0); ATT_LDK(kb, 2); __builtin_amdgcn_sched_barrier(0);
        ATT_QK(Sc, ka, 0); __builtin_amdgcn_sched_barrier(0); ATT_EXP1(Sp, 0); ATT_EXP1(Sp, 1); ATT_LDK(ka, 4); __builtin_amdgcn_sched_barrier(0);
        ATT_QK(Sc, kb, 2); __builtin_amdgcn_sched_barrier(0); ATT_EXP1(Sp, 2); ATT_EXP1(Sp, 3); ATT_LDK(kb, 6); __builtin_amdgcn_sched_barrier(0);
        ATT_QK(Sc, ka, 4); __builtin_amdgcn_sched_barrier(0); ATT_EXP1(Sp, 4); ATT_EXP1(Sp, 5);
        ka[0][0] = *(const LAS bf16x8*)(Kl + kaddr0 + 8 * 2048); ka[0][1] = *(const LAS bf16x8*)(Kl + kaddr1 + 8 * 2048); __builtin_amdgcn_sched_barrier(0);
        ATT_QK(Sc, kb, 6); __builtin_amdgcn_sched_barrier(0); ATT_EXP1(Sp, 6); ATT_EXP1(Sp, 7); __builtin_amdgcn_sched_barrier(0);
        ATT_QK8(Sc); __builtin_amdgcn_sched_barrier(0); ATT_EXP1(Sp, 8); __builtin_amdgcn_sched_barrier(0);
        ATT_FINISH(Sp, xp);
#pragma unroll
        for (int Tt = 0; Tt < 9; ++Tt) Sp[Tt] = Sc[Tt];
        if (u + 1 < u1) ATT_STAGEK(u + 1);
        ATT_STAGEV(u);
        __syncthreads();
    }
    {
        const UnitA xp = decode(ATT_UNIT(u1 - 1));
        const LAS unsigned char* Vl = F.lds + ((u1 - 1 - u0) & 1) * 65536 + 32768;
        ATT_MAX(Sp);
#pragma unroll
        for (int Tt = 0; Tt < 9; ++Tt) ATT_EXP1(Sp, Tt);
        ATT_FINISH(Sp, xp);
    }
#undef ATT_FINISH
#undef ATT_PV
#undef ATT_LDV
#undef ATT_EXP1
#undef ATT_MAX
#undef ATT_QK8
#undef ATT_QK
#undef ATT_LDK
#undef ATT_INIT
#undef ATT_STAGEV
#undef ATT_STAGEK
#undef ATT_LOADV
#undef ATT_LOADK
#undef ATT_UNIT
}
}


namespace lru {
typedef short bf16x8 __attribute__((ext_vector_type(8)));
constexpr int NUNITS = NBATCH * 16 * 4;
constexpr int CHK = 512, NCHK = SEQ / CHK;
constexpr int OFF_XR = 0, XR_BYTES = (CHK + 4) * 128, OFF_XG = 66560, XG_BYTES = CHK * 32, OFF_WT = OFF_XG + XG_BYTES, OFF_CW = OFF_WT + 2048;
static_assert(XR_BYTES <= OFF_XG && OFF_CW + 16384 <= 131072, "LRU LDS map");
__device__ __forceinline__ unsigned cvt_pk_bf16(float lo, float hi) { unsigned r; asm volatile("v_cvt_pk_bf16_f32 %0, %1, %2" : "=v"(r) : "v"(lo), "v"(hi)); return r; }
__device__ __forceinline__ float sigm(float x) { return __builtin_amdgcn_rcpf(1.f + __expf(-x)); }

__device__ __forceinline__ void lru_phase(const Frame& F, const Args& a) {
    const bf16_t* proj = (const bf16_t*)(a.ws + WS_B);
    const int tid = F.tid, lane = F.lane, w = F.wave, i = lane & 15, g = lane >> 4;
    LAS unsigned char* L = F.lds;
    LAS unsigned char* XR = L + OFF_XR;
    LAS unsigned char* XG = L + OFF_XG;
    for (int uid = blockIdx.x; uid < NUNITS; uid += gridDim.x) {
        const int pair_ = (gridDim.x == 256) ? ((uid & 7) * 8 + (uid >> 5)) : (uid >> 2), q4 = (gridDim.x == 256) ? ((uid >> 3) & 3) : (uid & 3);
        const int b = pair_ >> 4, blk = pair_ & 15;
        const int cblk = blk * 64, ce = cblk + q4 * 16 + i;
        __syncthreads();
        float gbias[2];
        {
            const float* WgA = a.in[4] + (size_t)blk * 64 * 64 + q4 * 16 + i; const float* WgX = a.in[6] + (size_t)blk * 64 * 64 + q4 * 16 + i;
            float wvA[2][8], wvX[2][8]; f32x4 cwq[4][2][2];
#pragma unroll
            for (int ks = 0; ks < 2; ++ks)
#pragma unroll
                for (int j = 0; j < 8; ++j) { wvA[ks][j] = WgA[(8 * g + j + 32 * ks) * 64]; wvX[ks][j] = WgX[(8 * g + j + 32 * ks) * 64]; }
#pragma unroll
            for (int jj = 0; jj < 4; ++jj)
#pragma unroll
                for (int ks = 0; ks < 2; ++ks) { const float* cp = a.in[2] + jj * DL + cblk + 8 * g + 32 * ks; cwq[jj][ks][0] = *(const f32x4*)cp; cwq[jj][ks][1] = *(const f32x4*)(cp + 4); }
#pragma unroll
            for (int ks = 0; ks < 2; ++ks)
#pragma unroll
                for (int jj = 0; jj < 4; ++jj) { v4u pa, px;
#pragma unroll
                    for (int j2 = 0; j2 < 4; ++j2) { const float c0 = cwq[jj][ks][j2 >> 1][(2 * j2) & 3], c1 = cwq[jj][ks][j2 >> 1][(2 * j2 + 1) & 3];
                        pa[j2] = cvt_pk_bf16(c0 * wvA[ks][2 * j2], c1 * wvA[ks][2 * j2 + 1]); px[j2] = cvt_pk_bf16(c0 * wvX[ks][2 * j2], c1 * wvX[ks][2 * j2 + 1]); }
                    if (w == 0) { *(LAS v4u*)(L + OFF_CW + (((0 * 4 + jj) * 2 + ks) * 64 + lane) * 16) = pa; *(LAS v4u*)(L + OFF_CW + (((1 * 4 + jj) * 2 + ks) * 64 + lane) * 16) = px; } }
            float gsA = a.in[5][ce], gsX = a.in[7][ce];
#pragma unroll 1
            for (int d0 = 0; d0 < 64; d0 += 16) { float ta[16], tx[16]; f32x4 cbv[4];
#pragma unroll
                for (int d = 0; d < 16; ++d) { ta[d] = WgA[(d0 + d) * 64]; tx[d] = WgX[(d0 + d) * 64]; }
#pragma unroll
                for (int q = 0; q < 4; ++q) cbv[q] = *(const f32x4*)(a.in[3] + cblk + d0 + 4 * q);
#pragma unroll
                for (int d = 0; d < 16; ++d) { const float cbd = cbv[d >> 2][d & 3]; gsA += cbd * ta[d]; gsX += cbd * tx[d]; } }
            gbias[0] = gsA; gbias[1] = gsX;
        }
        const float cw0 = a.in[2][0 * DL + ce], cw1 = a.in[2][1 * DL + ce], cw2 = a.in[2][2 * DL + ce], cw3 = a.in[2][3 * DL + ce], cb = a.in[3][ce];
        const float bA = gbias[0], bX = gbias[1];
        const float sp8 = 8.0f * log1pf(__expf(-a.in[8][ce]));
        float carry = 0.f;
        v4u sxr[8], sxr8, sxg[2];
        const bf16_t* xrb = proj + (size_t)b * SEQ * DP + 3 * DA + cblk + (tid & 7) * 8;
        const bf16_t* xgb = proj + (size_t)b * SEQ * DP + 3 * DA + DL + cblk + q4 * 16 + (tid & 1) * 8;
#define LRU_LOAD(CH) do { const int t0_ = CHK * (CH) - 4; \
            { int t = t0_ + (tid >> 3); const bool ok = t >= 0; t = ok ? t : 0; sxr[0] = *(const v4u*)(xrb + (size_t)t * DP); if (!ok) sxr[0] = (v4u){0u, 0u, 0u, 0u}; } \
            _Pragma("unroll") for (int k = 1; k < 8; ++k) sxr[k] = *(const v4u*)(xrb + (size_t)(t0_ + 64 * k + (tid >> 3)) * DP); \
            if (tid < 32) sxr8 = *(const v4u*)(xrb + (size_t)(t0_ + 512 + (tid >> 3)) * DP); \
            _Pragma("unroll") for (int k = 0; k < 2; ++k) sxg[k] = *(const v4u*)(xgb + (size_t)(t0_ + 4 + 256 * k + (tid >> 1)) * DP); } while (0)
        LRU_LOAD(0);
        for (int chk = 0; chk < NCHK; ++chk) {
            LAS float* WT = (LAS float*)(L + OFF_WT + (chk & 1) * 1024);
            __syncthreads();
#pragma unroll
            for (int k = 0; k < 8; ++k) { const int rr = 64 * k + (tid >> 3), cc = tid & 7; *(LAS v4u*)(XR + rr * 128 + ((cc ^ (rr & 7)) << 4)) = sxr[k]; }
            if (tid < 32) { const int rr = 512 + (tid >> 3), cc = tid & 7; *(LAS v4u*)(XR + rr * 128 + ((cc ^ (rr & 7)) << 4)) = sxr8; }
#pragma unroll
            for (int k = 0; k < 2; ++k) { const int rr = 256 * k + (tid >> 1), cc = tid & 1; *(LAS v4u*)(XG + rr * 32 + cc * 16) = sxg[k]; }
            __syncthreads();
            if (chk + 1 < NCHK) LRU_LOAD(chk + 1);
            int li = i, lg = g;
            asm volatile("" : "+v"(li), "+v"(lg));
            const int llane = lg * 16 + li;
            float av[4][4], uv[4][4], Ae[4], Be[4], Agt[4], Bgt[4];
#pragma unroll
            for (int gi = 0; gi < 4; ++gi) {
                const int tb = 64 * w + 16 * gi;
                f32x4 ga = (f32x4){0.f, 0.f, 0.f, 0.f}, gx = (f32x4){0.f, 0.f, 0.f, 0.f};
#pragma unroll
                for (int jj = 0; jj < 4; ++jj)
#pragma unroll
                    for (int ks = 0; ks < 2; ++ks) { const int rr = tb + li + 1 + jj, c8 = lg + 4 * ks;
                        const bf16x8 af = *(const LAS bf16x8*)(XR + rr * 128 + ((c8 ^ (rr & 7)) << 4));
                        const bf16x8 wA = *(const LAS bf16x8*)(L + OFF_CW + (((0 * 4 + jj) * 2 + ks) * 64 + llane) * 16), wX = *(const LAS bf16x8*)(L + OFF_CW + (((1 * 4 + jj) * 2 + ks) * 64 + llane) * 16);
                        ga = __builtin_amdgcn_mfma_f32_16x16x32_bf16(af, wA, ga, 0, 0, 0);
                        gx = __builtin_amdgcn_mfma_f32_16x16x32_bf16(af, wX, gx, 0, 0, 0); }
                float r7[7];
                { const int chn = q4 * 16 + li, c8 = chn >> 3, bo = (chn & 7) * 2;
#pragma unroll
                  for (int k = 0; k < 7; ++k) { const int rr = tb + 4 * lg + 1 + k; r7[k] = bf2f(*(const LAS bf16_t*)(XR + rr * 128 + ((c8 ^ (rr & 7)) << 4) + bo)); } }
#pragma unroll
                for (int j = 0; j < 4; ++j) {
                    const float xc = cb + r7[j] * cw0 + r7[j + 1] * cw1 + r7[j + 2] * cw2 + r7[j + 3] * cw3;
                    const float r = sigm(ga[j] + bA), ig = sigm(gx[j] + bX);
                    const float la = -r * sp8;
                    av[gi][j] = __expf(la);
                    uv[gi][j] = __builtin_amdgcn_sqrtf(fmaf(-av[gi][j], av[gi][j], 1.0f)) * (ig * xc);
                }
                float A = av[gi][0], B = uv[gi][0];
#pragma unroll
                for (int j = 1; j < 4; ++j) { B = av[gi][j] * B + uv[gi][j]; A *= av[gi][j]; }
                float Ai = A, Bi = B;
                { const float Ap = __shfl_up(Ai, 16), Bp = __shfl_up(Bi, 16); if (g >= 1) { Bi = Ai * Bp + Bi; Ai = Ai * Ap; } }
                { const float Ap = __shfl_up(Ai, 32), Bp = __shfl_up(Bi, 32); if (g >= 2) { Bi = Ai * Bp + Bi; Ai = Ai * Ap; } }
                Ae[gi] = __shfl_up(Ai, 16); Be[gi] = __shfl_up(Bi, 16); if (g == 0) { Ae[gi] = 1.f; Be[gi] = 0.f; }
                Agt[gi] = __shfl(Ai, 48 + i); Bgt[gi] = __shfl(Bi, 48 + i);
            }
            float Aw_ = Agt[0], Bw_ = Bgt[0];
#pragma unroll
            for (int gi = 1; gi < 4; ++gi) { Bw_ = Agt[gi] * Bw_ + Bgt[gi]; Aw_ *= Agt[gi]; }
            if (g == 0) { WT[(w * 16 + i) * 2] = Aw_; WT[(w * 16 + i) * 2 + 1] = Bw_; }
            __syncthreads();
            float hw = carry, hall = carry;
#pragma unroll
            for (int w2 = 0; w2 < 8; ++w2) { const float Aw = WT[(w2 * 16 + i) * 2], Bw = WT[(w2 * 16 + i) * 2 + 1]; hall = Aw * hall + Bw; if (w2 < w) hw = hall; }
            carry = hall;
            bf16_t* rec = (bf16_t*)((unsigned char*)a.out + DO_REC);
            float hg = hw;
#pragma unroll
            for (int gi = 0; gi < 4; ++gi) {
                float h = Ae[gi] * hg + Be[gi];
#pragma unroll
                for (int j = 0; j < 4; ++j) {
                    h = av[gi][j] * h + uv[gi][j];
                    const int tl = 64 * w + 16 * gi + 4 * lg + j;
                    const float xg = bf2f(*(const LAS bf16_t*)(XG + tl * 32 + li * 2));
                    const float uu = 1.5957691216057308f * (xg + 0.044715f * xg * xg * xg);
                    const float rv = h * xg * sigm(uu);
                    const size_t t = (size_t)b * SEQ + CHK * chk + tl;
                    rec[t * DL + ce] = (bf16_t)f2bf(rv);
                }
                hg = Agt[gi] * hg + Bgt[gi];
            }
        }
#undef LRU_LOAD
    }
}
}

#define XB_TMO      128
#define XB_XCNT(j)  (256  + 64 * (j))
#define XB_XSUB(j)  (1280 + 64 * (j))
#define XB_XGEN(j)  (2304 + 64 * (j))
#define XB_TOP      3328
#define XB_TOPGEN   3392
#define XCD_BAR_WORDS 3456
#define XB_SPIN_CAP (1u << 18)
__device__ __forceinline__ unsigned xb_ld(unsigned* p)              { return __hip_atomic_load(p, __ATOMIC_RELAXED, __HIP_MEMORY_SCOPE_AGENT); }
__device__ __forceinline__ unsigned xb_add(unsigned* p, unsigned v) { return __hip_atomic_fetch_add(p, v, __ATOMIC_RELAXED, __HIP_MEMORY_SCOPE_AGENT); }
__device__ __forceinline__ unsigned xb_xcc_id() { return (unsigned)__builtin_amdgcn_s_getreg((3 << 11) | 20) & 0xFu; }
#define XB_SPIN(cond, bar) do { unsigned _sp = 0; while (cond) { __builtin_amdgcn_s_sleep(1); \
    if ((++_sp & 255u) == 0u) { if (xb_ld(&(bar)[XB_TMO])) break; if (_sp > XB_SPIN_CAP) { atomicAdd(&(bar)[XB_TMO], 1u); break; } } } } while (0)
struct XcdBarrier { unsigned* bar; unsigned x; volatile LAS unsigned* st; };
__device__ __forceinline__ XcdBarrier xcd_barrier_post(unsigned* bar, volatile LAS unsigned* st) {
    XcdBarrier b; b.bar = bar; b.x = xb_xcc_id(); b.st = st;
    if (threadIdx.x == 0) (void)xb_add(&bar[XB_XCNT(b.x)], 1u);
    return b;
}
__device__ __forceinline__ void xcd_barrier_complete(unsigned* bar, unsigned x, unsigned& nloc, unsigned& nx) {
    const unsigned G = gridDim.x * gridDim.y * gridDim.z;
    unsigned sum, cnt, mine, sp = 0u;
    for (;;) {
        sum = 0u; cnt = 0u; mine = 0u;
#pragma unroll
        for (unsigned j = 0; j < 16; ++j) { const unsigned c = xb_ld(&bar[XB_XCNT(j)]); sum += c; cnt += (c > 0u) ? 1u : 0u; mine = (j == x) ? c : mine; }
        if (sum == G) break;
        __builtin_amdgcn_s_sleep(1);
        if ((++sp & 255u) == 0u) { if (xb_ld(&bar[XB_TMO])) break; if (sp > XB_SPIN_CAP) { atomicAdd(&bar[XB_TMO], 1u); break; } }
    }
    nloc = mine > 0u ? mine : 1u; nx = cnt > 0u ? cnt : 1u;
}
__device__ __forceinline__ void xcd_barrier(const XcdBarrier& b) {
    asm volatile("s_waitcnt vmcnt(0)" ::: "memory");
    __syncthreads();
    if (threadIdx.x == 0) {
        unsigned* bar = b.bar;
        __builtin_amdgcn_s_waitcnt(0);
        unsigned nloc = b.st[0], nx = b.st[1];
        if (nloc == 0u) { xcd_barrier_complete(bar, b.x, nloc, nx); b.st[0] = nloc; b.st[1] = nx; }
        const unsigned old = xb_add(&bar[XB_XSUB(b.x)], 1u);
        const unsigned gen = old / nloc;
        if (old + 1u == (gen + 1u) * nloc) {
            __builtin_amdgcn_fence(__ATOMIC_RELEASE, "agent");
            asm volatile("s_waitcnt vmcnt(0)" ::: "memory");
            const unsigned og = xb_add(&bar[XB_TOP], 1u);
            const unsigned tg = og / nx;
            if (og + 1u == (tg + 1u) * nx) xb_add(&bar[XB_TOPGEN], 1u);
            else XB_SPIN(xb_ld(&bar[XB_TOPGEN]) == tg, bar);
            __builtin_amdgcn_fence(__ATOMIC_ACQUIRE, "agent");
            xb_add(&bar[XB_XGEN(b.x)], 1u);
            asm volatile("s_waitcnt vmcnt(0)" ::: "memory");
        } else {
            XB_SPIN(xb_ld(&bar[XB_XGEN(b.x)]) == gen, bar);
            __builtin_amdgcn_fence(__ATOMIC_ACQUIRE, "agent");
            asm volatile("s_waitcnt vmcnt(0)" ::: "memory");
        }
    }
    __syncthreads();
}

#ifndef PROBE_PH
#define PROBE_PH -1
#endif
#define NREP(k) (((k) == PROBE_PH) ? 3 : 1)
#ifndef UP_SP2
#define UP_SP2 true
#endif
enum Phase { PH_CONVERT = 0, PH_GEMM1, PH_ATTN_LRU, PH_COMBINE, PH_GEMM2, PH_LN1, PH_MOE, PH_FINAL, PH_N };


__global__ void __launch_bounds__(NTHR, 2) mega(Args args) {
    extern __shared__ __attribute__((aligned(16))) unsigned char lds[];
    Frame F; F.lds = (LAS unsigned char*)lds; F.tid = threadIdx.x; F.lane = F.tid & 63; F.wave = __builtin_amdgcn_readfirstlane(F.tid >> 6);
    F.gw = blockIdx.x * NWAVES + F.wave; F.ngw = gridDim.x * NWAVES;
#define FRAME(Fn) Frame Fn; { int t_ = threadIdx.x; asm volatile("" : "+v"(t_)); Fn.lds = (LAS unsigned char*)lds; Fn.tid = t_; Fn.lane = t_ & 63; Fn.wave = __builtin_amdgcn_readfirstlane(t_ >> 6); \
        Fn.gw = blockIdx.x * NWAVES + Fn.wave; Fn.ngw = gridDim.x * NWAVES; }
    const int lo = args.lo, hi = args.hi;
    volatile LAS unsigned* bst = (volatile LAS unsigned*)(F.lds + BARST_OFF);
    if (F.tid < 4) bst[F.tid] = 0u;
    __syncthreads();
    XcdBarrier bar; bar.bar = (unsigned*)(args.ws + WS_CTL) + CW_BAR; bar.x = 0; bar.st = bst;
    if (hi - lo > 1) bar = xcd_barrier_post((unsigned*)(args.ws + WS_CTL) + CW_BAR, bst);
#define IN(k) (lo <= (k) && (k) < hi)
#define SEAM(k) do { if (IN(k) && IN((k) + 1)) xcd_barrier(bar); } while (0)
    if (IN(PH_CONVERT)) phase_convert(F, args);
    SEAM(PH_CONVERT);
    if (IN(PH_GEMM1)) {
        const int cls = ((int)blockIdx.x >> 3) & 3, ks = (cls == 0) ? 0 : (cls == 1 ? 1 : (cls == 2 ? 3 : (1 << 29)));
        g8::ProbProj P; P.A = (const char*)(args.ws + WS_D); P.Bt = (const char*)(args.ws + WS_WIN); P.C = (bf16_t*)(args.ws + WS_B); P.ord.init(T, DP, gridDim.x, blockIdx.x);
        P.ord.i0 = 0; P.ord.i1 = ks;
        g8::gemm_phase(F.lds, P);
        __syncthreads();
        convert_rest(F, args);
        __syncthreads();
        P.ord.i0 = ks; P.ord.i1 = 1 << 30;
        g8::gemm_phase(F.lds, P);
    }
    SEAM(PH_GEMM1);
    if (IN(PH_ATTN_LRU)) { lru::lru_phase(F, args); att::attn_phase(F, args); }
    SEAM(PH_ATTN_LRU);
    if (IN(PH_COMBINE)) phase_combine(F, args);
    SEAM(PH_COMBINE);
#define DO_GEMM2() {         g8::ProbOut P; P.A = (const char*)(args.ws + WS_Y); P.Bt = (const char*)(args.ws + WS_WOUT); P.C = (bf16_t*)(args.ws + WS_B); P.ord.init(T, D, gridDim.x, blockIdx.x);         g8::gemm_phase(F.lds, P);     }
    if (IN(PH_GEMM2)) { DO_GEMM2(); if (NREP(PH_GEMM2) > 1) { DO_GEMM2(); DO_GEMM2(); } }
    SEAM(PH_GEMM2);
    if (IN(PH_LN1)) phase_ln1_router(F, args);
    SEAM(PH_LN1);
    if (IN(PH_MOE) || IN(PH_FINAL)) {
        LAS int* toff = (LAS int*)(F.lds + MISC_OFF);
        const unsigned* cnt = (const unsigned*)(args.ws + WS_CTL) + CW_CNT;
        if (F.tid == 0) { int acc = 0; for (int e = 0; e < NE; ++e) { const int c = (int)cnt[e]; toff[e] = acc; toff[64 + e] = c; acc += (c + 255) >> 8; } toff[NE] = acc; toff[128 + 3] = -1; }
        __syncthreads();
    }
    if (IN(PH_MOE)) {
        g8::MoeQueue Q; Q.toff = (const LAS int*)(F.lds + MISC_OFF); Q.slots = (LAS int*)(F.lds + MISC_OFF + 512);
        Q.qhead = (unsigned*)(args.ws + WS_CTL) + CW_QHEAD; Q.ready = (unsigned*)(args.ws + WS_CTL) + CW_READY; Q.tmo = (unsigned*)(args.ws + WS_CTL) + CW_BAR + XB_TMO;
        {
            g8::ProbUp P; P.A = (const char*)(args.ws + WS_X8); P.Bt = (const char*)(args.ws + WS_W13); P.H = (unsigned char*)(args.ws + WS_D); P.rowtok = (const int*)(args.ws + WS_ROUTE + RT_ROWTOK); P.q = Q;
            g8::gemm_phase<g8::ProbUp, UP_SP2>(F.lds, P);
        }
        {
            g8::ProbDown P; P.A = (const char*)(args.ws + WS_D); P.Bt = (const char*)(args.ws + WS_W2); P.Y = (unsigned char*)(args.ws + WS_B); P.q = Q;
            g8::gemm_phase(F.lds, P);
        }
    }
    SEAM(PH_MOE);
    if (IN(PH_FINAL)) phase_final(F, args);
#undef IN
#undef SEAM
}

extern "C" void kernel_launch(void* const* d_in, const int* in_sizes, int n_in, void* d_out, int out_size, void* d_ws, size_t ws_size, hipStream_t stream) {
    static int grid = 0;
    if (grid == 0) {
        if (n_in != 23 || out_size != T * D || ws_size < WS_END) { fprintf(stderr, "kernel_launch: unexpected shapes (n_in %d out %d ws %zu)\n", n_in, out_size, ws_size); grid = -1; return; }
        int dev = 0, cus = 0;
        if (hipGetDevice(&dev) != hipSuccess || hipDeviceGetAttribute(&cus, hipDeviceAttributeMultiprocessorCount, dev) != hipSuccess) { grid = -1; return; }
        if (hipFuncSetAttribute((const void*)mega, hipFuncAttributeMaxDynamicSharedMemorySize, LDS_BYTES) != hipSuccess) { grid = -1; return; }
        grid = cus;
    }
    if (grid < 0) return;
    (void)in_sizes;
    hipMemsetAsync((char*)d_ws + WS_CTL, 0, CTL_BYTES, stream);
    Args a{};
    for (int i = 0; i < 23; ++i) a.in[i] = (const float*)d_in[i];
    a.out = (float*)d_out; a.ws = (unsigned char*)d_ws; a.lo = 0; a.hi = 0;
    auto run = [&](int lo, int hi) { a.lo = lo; a.hi = hi; hipLaunchKernelGGL(mega, dim3(grid), dim3(NTHR), LDS_BYTES, stream, a); };
#if defined(MK_PER_PHASE)
    for (int ph = 0; ph < PH_N; ++ph) run(ph, ph + 1);
#else
    run(0, PH_N);
#endif
}
```

```cpp
#include <hip/hip_runtime.h>
#include <stdint.h>
#include <stdio.h>

#define GAS __attribute__((address_space(1)))
#define LAS __attribute__((address_space(3)))
typedef unsigned short bf16_t;
typedef unsigned v4u __attribute__((ext_vector_type(4)));
typedef unsigned v2u __attribute__((ext_vector_type(2)));
typedef float f32x4 __attribute__((ext_vector_type(4)));

constexpr int T = 16384, SEQ = 4096, NBATCH = 4, D = 2048, DP = 5120, DA = 1024, DL = 1024, NH = 16, HD = 64;
constexpr int NE = 32, DE = 512, NGRP = 4, EPG = 8;
constexpr int PMAX = 40960;
constexpr float ALPHA = 1.189207115002721f;
constexpr float LN_EPS = 1e-5f, RMS_EPS = 1e-6f;
constexpr int NWAVES = 8, NTHR = 512;
constexpr int LDS_BYTES = 163840, MISC_OFF = 131072 + 1024, BARST_OFF = 131072 + 2048;

constexpr size_t MiB = 1u << 20;
constexpr size_t WS_CTL = 0, CTL_BYTES = 1 * MiB;
constexpr size_t WS_WIN = 1 * MiB;
constexpr size_t WS_WOUT = 21 * MiB;
constexpr size_t WS_W13 = 29 * MiB;
constexpr size_t WS_Y = 93 * MiB;
constexpr size_t WS_W2 = 157 * MiB;
constexpr size_t WS_B = 221 * MiB;
constexpr size_t WS_X1B_OFF = 64 * MiB;
constexpr size_t WS_D = 381 * MiB;
constexpr size_t WS_LSE = 445 * MiB;
constexpr size_t WS_SSQR = 448 * MiB;
constexpr size_t WS_ROUTE = 452 * MiB;
constexpr size_t WS_X1F = 456 * MiB;
constexpr size_t WS_X8 = 520 * MiB;
constexpr size_t WS_END = 552 * MiB;
constexpr size_t RT_E = 0;
constexpr size_t RT_W = 131072;
constexpr size_t RT_RANK = 262144;
constexpr size_t RT_POS = 393216;
constexpr size_t RT_ROWTOK = 2097152;
constexpr size_t RT_WR = 1048576;
constexpr int CW_CNT = 64;
constexpr int CW_BAR = 4096;
constexpr int CW_QHEAD = 128;
constexpr int CW_READY = 8192;

constexpr size_t DO_O = 0, DO_OSTRIDE = (size_t)T * DA * 2, DO_REC = 3 * DO_OSTRIDE;

__device__ __forceinline__ float bf2f(bf16_t b) { return __uint_as_float(((unsigned)b) << 16); }
__device__ __forceinline__ unsigned f2bf(float f) { unsigned u = __float_as_uint(f); return (u + 0x7fffu + ((u >> 16) & 1u)) >> 16; }
__device__ __forceinline__ unsigned pk2(float lo, float hi) { unsigned r; asm("v_cvt_pk_bf16_f32 %0, %1, %2" : "=v"(r) : "v"(lo), "v"(hi)); return r; }
__device__ __forceinline__ float wave_sum(float v) {
#pragma unroll
    for (int o = 1; o < 64; o <<= 1) v += __shfl_xor(v, o);
    return v;
}
__device__ __forceinline__ float sigmoidf_(float x) { return 1.f / (1.f + __expf(-x)); }
__device__ __forceinline__ float gelu_tanh(float x) { const float u = 0.7978845608028654f * (x + 0.044715f * x * x * x); return 0.5f * x * (1.f + tanhf(u)); }

struct Args {
    const float* in[23];
    float* out;
    unsigned char* ws;
    int lo, hi;
};

struct Frame {
    LAS unsigned char* lds;
    int tid, lane, wave, gw, ngw;
};

__device__ __forceinline__ void transpose_item(const float* W, int K, int N, bf16_t* WT, int mode, LAS unsigned char* scr, int item, int lane) {
    const int kblk = K / 64, nb = item / kblk, kb = item - nb * kblk, k0 = 64 * kb, n0 = 64 * nb;
    int drow0 = n0;
    if (mode == 1) drow0 = (n0 / 128) * 256 + (n0 % 128);
    if (mode == 2) drow0 = (n0 / 128) * 256 + 128 + (n0 % 128);
    const int r4 = lane >> 4, c = lane & 15;
    f32x4 v[16];
    const float* src = W + (size_t)(k0 + 2 * r4) * N + n0 + 4 * c;
#pragma unroll
    for (int j = 0; j < 8; ++j) { v[2 * j] = *(const f32x4*)(src + (size_t)(8 * j) * N); v[2 * j + 1] = *(const f32x4*)(src + (size_t)(8 * j + 1) * N); }
#pragma unroll
    for (int j = 0; j < 8; ++j)
#pragma unroll
        for (int q = 0; q < 4; ++q) { const int n = 4 * c + q;
            *(LAS unsigned*)(scr + n * 128 + ((j ^ (c & 7)) << 4) + 4 * r4) = pk2(v[2 * j][q], v[2 * j + 1][q]); }
    asm volatile("s_waitcnt lgkmcnt(0)" ::: "memory");
    const int ch = lane & 7;
#pragma unroll
    for (int j = 0; j < 8; ++j) { const int n = 8 * j + (lane >> 3);
        const v4u o = *(const LAS v4u*)(scr + n * 128 + ((ch ^ ((n >> 2) & 7)) << 4));
        *(v4u*)(WT + (size_t)(drow0 + n) * K + k0 + 8 * ch) = o; }
    asm volatile("s_waitcnt lgkmcnt(0)" ::: "memory");
}

__device__ __forceinline__ void phase_convert(const Frame& F, const Args& a) {
    unsigned char* ws = a.ws;
    {
        const float* x = a.in[0]; bf16_t* xb = (bf16_t*)(ws + WS_D);
        const size_t nch = (size_t)T * D / 8;
        for (size_t i = (size_t)F.gw * 256 + F.lane; i < nch; i += (size_t)F.ngw * 256) {
            f32x4 v0[4], v1[4];
#pragma unroll
            for (int q = 0; q < 4; ++q) { v0[q] = *(const f32x4*)(x + (i + 64 * q) * 8); v1[q] = *(const f32x4*)(x + (i + 64 * q) * 8 + 4); }
#pragma unroll
            for (int q = 0; q < 4; ++q) { v4u o; o.x = pk2(v0[q].x, v0[q].y); o.y = pk2(v0[q].z, v0[q].w); o.z = pk2(v1[q].x, v1[q].y); o.w = pk2(v1[q].z, v1[q].w);
                *(v4u*)(xb + (i + 64 * q) * 8) = o; }
        }
    }
    {
        bf16_t* WrT = (bf16_t*)(ws + WS_ROUTE + RT_WR);
        for (int idx = F.gw * 64 + F.lane; idx < 48 * D; idx += F.ngw * 64) {
            const int j = idx & 7, ln = (idx >> 3) & 63, blk = idx >> 9;
            const int nt = blk % 3, wk = blk / 3, col = 16 * nt + (ln & 15), k = 32 * wk + 8 * (ln >> 4) + j;
            const float wv = (col < 4) ? a.in[14][k * NGRP + col] : ((col < 36) ? a.in[16][k * NE + (col - 4)] : 0.f);
            const unsigned hb = pk2(wv, 0.f) & 0xffffu; const float hf = __uint_as_float(hb << 16);
            WrT[(size_t)(2 * blk) * 512 + ln * 8 + j] = (bf16_t)hb; WrT[(size_t)(2 * blk + 1) * 512 + ln * 8 + j] = (bf16_t)(pk2(wv - hf, 0.f) & 0xffffu); }
    }
    LAS unsigned char* scr = F.lds + F.wave * 8192;
    constexpr int I_IN = (D / 64) * (DP / 64);
    { const int run = (I_IN + F.ngw - 1) / F.ngw; for (int r = 0; r < run; ++r) { const int it = F.gw * run + r; if (it < I_IN) transpose_item(a.in[1], D, DP, (bf16_t*)(ws + WS_WIN), 0, scr, it, F.lane); } }
}
__device__ __forceinline__ void transpose_item8(const float* W, int K, int N, unsigned char* WT, int mode, LAS unsigned char* scr, int item, int lane) {
    const int kblk = K / 64, nb = item / kblk, kb = item - nb * kblk, k0 = 64 * kb, n0 = 64 * nb;
    int drow0 = n0;
    if (mode == 1) drow0 = (n0 / 128) * 256 + (n0 % 128);
    if (mode == 2) drow0 = (n0 / 128) * 256 + 128 + (n0 % 128);
    const int r4 = lane >> 4, c = lane & 15;
    f32x4 v[16];
    const float* src = W + (size_t)(k0 + 4 * r4) * N + n0 + 4 * c;
#pragma unroll
    for (int j = 0; j < 4; ++j)
#pragma unroll
        for (int s4 = 0; s4 < 4; ++s4) v[4 * j + s4] = *(const f32x4*)(src + (size_t)(16 * j + s4) * N);
#pragma unroll
    for (int j = 0; j < 4; ++j)
#pragma unroll
        for (int q = 0; q < 4; ++q) { const int n = 4 * c + q;
            int pk = 0;
            pk = __builtin_amdgcn_cvt_pk_fp8_f32(v[4 * j][q] * 64.f, v[4 * j + 1][q] * 64.f, pk, false);
            pk = __builtin_amdgcn_cvt_pk_fp8_f32(v[4 * j + 2][q] * 64.f, v[4 * j + 3][q] * 64.f, pk, true);
            *(LAS int*)(scr + n * 64 + ((j ^ (c & 3)) << 4) + 4 * r4) = pk; }
    asm volatile("s_waitcnt lgkmcnt(0)" ::: "memory");
    const int pch = lane & 3;
#pragma unroll
    for (int j = 0; j < 4; ++j) { const int n = 16 * j + (lane >> 2);
        const v4u o = *(const LAS v4u*)(scr + n * 64 + ((pch ^ ((n >> 2) & 3)) << 4));
        *(v4u*)(WT + (size_t)(drow0 + n) * K + k0 + 16 * pch) = o; }
    asm volatile("s_waitcnt lgkmcnt(0)" ::: "memory");
}
__device__ __forceinline__ void convert_rest(const Frame& F, const Args& a) {
    unsigned char* ws = a.ws;
    LAS unsigned char* scr = F.lds + F.wave * 8192;
    constexpr int I_OUT = (D / 64) * (D / 64), I_E13 = (D / 64) * (DE / 64), I_E2 = (DE / 64) * (D / 64);
    constexpr int NITEMS = I_OUT + NE * (2 * I_E13 + I_E2);
    const int run_ = (NITEMS + F.ngw - 1) / F.ngw;
    for (int rr_ = 0; rr_ < run_; ++rr_) {
        const int it = F.gw * run_ + rr_; if (it >= NITEMS) break;
        int r = it;
        if (r < I_OUT) { transpose_item(a.in[11], D, D, (bf16_t*)(ws + WS_WOUT), 0, scr, r, F.lane); continue; } r -= I_OUT;
        const int per_e = 2 * I_E13 + I_E2, e = r / per_e; r -= e * per_e;
        if (r < I_E13) { transpose_item8(a.in[18] + (size_t)e * D * DE, D, DE, (unsigned char*)(ws + WS_W13) + (size_t)e * 1024 * D, 1, scr, r, F.lane); continue; } r -= I_E13;
        if (r < I_E13) { transpose_item8(a.in[19] + (size_t)e * D * DE, D, DE, (unsigned char*)(ws + WS_W13) + (size_t)e * 1024 * D, 2, scr, r, F.lane); continue; } r -= I_E13;
        transpose_item8(a.in[20] + (size_t)e * DE * D, DE, D, (unsigned char*)(ws + WS_W2) + (size_t)e * D * DE, 0, scr, r, F.lane);
    }
}

__device__ __forceinline__ void phase_combine(const Frame& F, const Args& a) {
    const unsigned char* dob = (const unsigned char*)a.out;
    const float* lse = (const float*)(a.ws + WS_LSE);
    bf16_t* y = (bf16_t*)(a.ws + WS_Y);
    const int lane = F.lane, h = lane >> 2;
    float gav[16], grv[16];
#pragma unroll
    for (int j = 0; j < 4; ++j) { const f32x4 ta = *(const f32x4*)(a.in[9] + 16 * lane + 4 * j), tr = *(const f32x4*)(a.in[10] + 16 * lane + 4 * j);
        gav[4 * j] = ta.x; gav[4 * j + 1] = ta.y; gav[4 * j + 2] = ta.z; gav[4 * j + 3] = ta.w; grv[4 * j] = tr.x; grv[4 * j + 1] = tr.y; grv[4 * j + 2] = tr.z; grv[4 * j + 3] = tr.w; }
    for (int t = F.gw; t < T; t += F.ngw) {
        const float l0 = lse[(size_t)(0 * T + t) * NH + h], l1 = lse[(size_t)(1 * T + t) * NH + h], l2 = lse[(size_t)(2 * T + t) * NH + h];
        v4u oa[3][2], rr[2];
#pragma unroll
        for (int pp = 0; pp < 3; ++pp) { const v4u* po = (const v4u*)(dob + DO_O + (size_t)pp * DO_OSTRIDE + ((size_t)t * DA + 16 * lane) * 2); oa[pp][0] = po[0]; oa[pp][1] = po[1]; }
        { const v4u* pr = (const v4u*)(dob + DO_REC + ((size_t)t * DL + 16 * lane) * 2); rr[0] = pr[0]; rr[1] = pr[1]; }
        const float mx = fmaxf(l0, fmaxf(l1, l2));
        float w0 = __expf(l0 - mx), w1 = __expf(l1 - mx), w2 = __expf(l2 - mx);
        const float inv = 1.f / (w0 + w1 + w2); w0 *= inv; w1 *= inv; w2 *= inv;
        float v[16], rv[16]; float ss = 0.f, sr = 0.f;
#pragma unroll
        for (int q = 0; q < 2; ++q)
#pragma unroll
            for (int j = 0; j < 4; ++j) {
                const unsigned u0 = oa[0][q][j], u1 = oa[1][q][j], u2 = oa[2][q][j], ur = rr[q][j];
                const float lo = w0 * __uint_as_float(u0 << 16) + w1 * __uint_as_float(u1 << 16) + w2 * __uint_as_float(u2 << 16);
                const float hi = w0 * __uint_as_float(u0 & 0xffff0000u) + w1 * __uint_as_float(u1 & 0xffff0000u) + w2 * __uint_as_float(u2 & 0xffff0000u);
                v[q * 8 + 2 * j] = lo; v[q * 8 + 2 * j + 1] = hi; ss += lo * lo + hi * hi;
                const float rl = __uint_as_float(ur << 16), rh = __uint_as_float(ur & 0xffff0000u);
                rv[q * 8 + 2 * j] = rl; rv[q * 8 + 2 * j + 1] = rh; sr += rl * rl + rh * rh;
            }
        ss = wave_sum(ss); sr = wave_sum(sr);
        const float rsa = 1.f / sqrtf(ss * (1.f / DA) + RMS_EPS), rsr = 1.f / sqrtf(sr * (1.f / DL) + RMS_EPS);
        v4u o[2], o2[2];
#pragma unroll
        for (int q = 0; q < 2; ++q)
#pragma unroll
            for (int j = 0; j < 4; ++j) { const int c = q * 8 + 2 * j;
                o[q][j] = pk2(v[c] * rsa * gav[c], v[c + 1] * rsa * gav[c + 1]); o2[q][j] = pk2(rv[c] * rsr * grv[c], rv[c + 1] * rsr * grv[c + 1]); }
        { v4u* dst = (v4u*)(y + (size_t)t * D + 16 * lane); dst[0] = o[0]; dst[1] = o[1]; }
        { v4u* dst = (v4u*)(y + (size_t)t * D + DA + 16 * lane); dst[0] = o2[0]; dst[1] = o2[1]; }
    }
}

constexpr int LN1_ROW = 8208;
__device__ __forceinline__ void phase_ln1_router(const Frame& F, const Args& a) {
    bf16_t* x1b = (bf16_t*)(a.ws + WS_X1F); unsigned char* x1f8 = (unsigned char*)(a.ws + WS_X8); const bf16_t* mixb = (const bf16_t*)(a.ws + WS_B); const bf16_t* xbb = (const bf16_t*)(a.ws + WS_D);
    const float* g1 = a.in[12]; const float* b1 = a.in[13];
    const float* gb = a.in[15]; const float* eb = a.in[17];
    const bf16_t* WrT = (const bf16_t*)(a.ws + WS_ROUTE + RT_WR);
    int* rt_e = (int*)(a.ws + WS_ROUTE + RT_E); float* rt_w = (float*)(a.ws + WS_ROUTE + RT_W); int* rt_rank = (int*)(a.ws + WS_ROUTE + RT_RANK);
    unsigned* cnt = (unsigned*)(a.ws + WS_CTL) + CW_CNT; int* rowtok = (int*)(a.ws + WS_ROUTE + RT_ROWTOK);
    const int lane = F.lane, i = lane & 15, g = lane >> 4, w = F.wave;
    LAS unsigned char* L = F.lds;
    LAS float* rbias = (LAS float*)(F.lds + 131072 + 3072);
    if (F.tid < 48) rbias[F.tid] = (F.tid < 4) ? gb[F.tid] : ((F.tid < 36) ? eb[F.tid - 4] : 0.f);
    LAS int* elist = (LAS int*)(F.lds + 131072 + 3584); LAS int* lcnt = elist + 64;
    LAS unsigned char* PT = F.lds + 131072 + 5120;
    for (int tb = blockIdx.x; tb < T / 64; tb += gridDim.x) {
        __syncthreads();
#pragma unroll 1
        for (int sb = 0; sb < 4; ++sb) {
            v2u xv2[2][8], mv2[2][8];
#pragma unroll
            for (int q = 0; q < 2; ++q)
#pragma unroll
                for (int j = 0; j < 8; ++j) { const size_t o = (size_t)(64 * tb + 16 * sb + 2 * w + q) * D + 4 * lane + 256 * j; xv2[q][j] = *(const v2u*)(xbb + o); mv2[q][j] = *(const v2u*)(mixb + o); }
#pragma unroll
            for (int q = 0; q < 2; ++q) {
                const int tl = 2 * w + q, t = 64 * tb + 16 * sb + tl;
                f32x4 v[8]; float s = 0.f;
#pragma unroll
                for (int j = 0; j < 8; ++j) { const v2u xq = xv2[q][j]; const v2u mq = mv2[q][j];
                    v[j].x = ALPHA * __uint_as_float(xq.x << 16) + __uint_as_float(mq.x << 16); v[j].y = ALPHA * __uint_as_float(xq.x & 0xffff0000u) + __uint_as_float(mq.x & 0xffff0000u);
                    v[j].z = ALPHA * __uint_as_float(xq.y << 16) + __uint_as_float(mq.y << 16); v[j].w = ALPHA * __uint_as_float(xq.y & 0xffff0000u) + __uint_as_float(mq.y & 0xffff0000u);
                    s += (v[j].x + v[j].y) + (v[j].z + v[j].w); }
                const float mean = wave_sum(s) * (1.f / D); float s2 = 0.f;
#pragma unroll
                for (int j = 0; j < 8; ++j) { v[j] = v[j] - mean; s2 += (v[j].x * v[j].x + v[j].y * v[j].y) + (v[j].z * v[j].z + v[j].w * v[j].w); }
                const float rstd = 1.f / sqrtf(wave_sum(s2) * (1.f / D) + LN_EPS);
#pragma unroll
                for (int jh = 0; jh < 2; ++jh) {
                    f32x4 gg[4], bb[4];
#pragma unroll
                    for (int j4 = 0; j4 < 4; ++j4) { const int c = 4 * lane + 256 * (4 * jh + j4); gg[j4] = *(const f32x4*)(g1 + c); bb[j4] = *(const f32x4*)(b1 + c); }
#pragma unroll
                    for (int j4 = 0; j4 < 4; ++j4) {
                        const int j = 4 * jh + j4, c = 4 * lane + 256 * j;
                        v[j] = v[j] * rstd * gg[j4] + bb[j4];
                        *(LAS f32x4*)(L + tl * LN1_ROW + c * 4) = v[j];
                        v2u o; o.x = pk2(v[j].x, v[j].y); o.y = pk2(v[j].z, v[j].w);
                        *(v2u*)(x1b + (size_t)t * D + c) = o;
                        int p8 = 0; p8 = __builtin_amdgcn_cvt_pk_fp8_f32(v[j].x, v[j].y, p8, false); p8 = __builtin_amdgcn_cvt_pk_fp8_f32(v[j].z, v[j].w, p8, true);
                        *(int*)(x1f8 + (size_t)t * D + c) = p8;
                    }
                }
            }
            __syncthreads();
            f32x4 c0 = (f32x4){0.f, 0.f, 0.f, 0.f}, c1 = c0, c2 = c0;
            {
                typedef short bf16x8_ __attribute__((ext_vector_type(8)));
                const LAS unsigned char* xa = L + i * LN1_ROW + (256 * w + 8 * g) * 4;
                const bf16_t* wb = WrT + (size_t)(w * 8) * 3 * 2 * 512 + lane * 8;
                v4u wf[6], wn[6];
#define LN1_LDW(dst, ks_) do { _Pragma("unroll") for (int nt = 0; nt < 3; ++nt) { dst[2 * nt] = *(const v4u*)(wb + (size_t)((((ks_) * 3 + nt) * 2) * 512)); dst[2 * nt + 1] = *(const v4u*)(wb + (size_t)((((ks_) * 3 + nt) * 2 + 1) * 512)); } } while (0)
                LN1_LDW(wf, 0);
#pragma unroll
                for (int ks = 0; ks < 8; ++ks) {
                    if (ks + 1 < 8) LN1_LDW(wn, ks + 1);
                    const f32x4 x0 = *(const LAS f32x4*)(xa + 128 * ks), x1 = *(const LAS f32x4*)(xa + 128 * ks + 16);
                    v4u hi, lo;
                    hi.x = pk2(x0.x, x0.y); hi.y = pk2(x0.z, x0.w); hi.z = pk2(x1.x, x1.y); hi.w = pk2(x1.z, x1.w);
                    lo.x = pk2(x0.x - __uint_as_float(hi.x << 16), x0.y - __uint_as_float(hi.x & 0xffff0000u)); lo.y = pk2(x0.z - __uint_as_float(hi.y << 16), x0.w - __uint_as_float(hi.y & 0xffff0000u));
                    lo.z = pk2(x1.x - __uint_as_float(hi.z << 16), x1.y - __uint_as_float(hi.z & 0xffff0000u)); lo.w = pk2(x1.z - __uint_as_float(hi.w << 16), x1.w - __uint_as_float(hi.w & 0xffff0000u));
                    const bf16x8_ ah = __builtin_bit_cast(bf16x8_, hi), al = __builtin_bit_cast(bf16x8_, lo);
#define LN1_RT(cacc, nt) do { const bf16x8_ wh = __builtin_bit_cast(bf16x8_, wf[2 * (nt)]), wl = __builtin_bit_cast(bf16x8_, wf[2 * (nt) + 1]); \
                        cacc = __builtin_amdgcn_mfma_f32_16x16x32_bf16(ah, wh, cacc, 0, 0, 0); cacc = __builtin_amdgcn_mfma_f32_16x16x32_bf16(ah, wl, cacc, 0, 0, 0); cacc = __builtin_amdgcn_mfma_f32_16x16x32_bf16(al, wh, cacc, 0, 0, 0); } while (0)
                    LN1_RT(c0, 0); LN1_RT(c1, 1); LN1_RT(c2, 2);
#undef LN1_RT
#pragma unroll
                    for (int q6 = 0; q6 < 6; ++q6) wf[q6] = wn[q6];
                }
#undef LN1_LDW
            }
            { LAS f32x4* xp = (LAS f32x4*)(PT + (w * 64 + lane) * 48); xp[0] = c0; xp[1] = c1; xp[2] = c2; }
            __syncthreads();
            if (w == 0) {
                const float bias0 = rbias[i], bias1 = rbias[16 + i], bias2 = rbias[32 + i];
                c0 = (f32x4){0.f, 0.f, 0.f, 0.f}; c1 = c0; c2 = c0;
#pragma unroll
                for (int w2 = 0; w2 < 8; ++w2) { const LAS f32x4* xp = (const LAS f32x4*)(PT + (w2 * 64 + lane) * 48); c0 += xp[0]; c1 += xp[1]; c2 += xp[2]; }
                LAS float* lgs = (LAS float*)(PT + 24576);
#pragma unroll
                for (int r = 0; r < 4; ++r) { LAS float* lp = lgs + (4 * g + r) * 48 + i; lp[0] = c0[r] + bias0; lp[16] = c1[r] + bias1; lp[32] = c2[r] + bias2; }
                asm volatile("s_waitcnt lgkmcnt(0)" ::: "memory");
                if (lane < 16) {
                    const int t = 64 * tb + 16 * sb + lane;
                    const LAS float* lp = lgs + lane * 48;
                    float pg[4]; float mg = -1e30f; int gi = 0;
#pragma unroll
                    for (int gq = 0; gq < 4; ++gq) { pg[gq] = lp[gq]; if (pg[gq] > mg) { mg = pg[gq]; gi = gq; } }
                    float sg = 0.f;
#pragma unroll
                    for (int gq = 0; gq < 4; ++gq) sg += __expf(pg[gq] - mg);
                    const float ggate = 1.f / sg;
                    float el[8];
#pragma unroll
                    for (int e = 0; e < 8; ++e) el[e] = lp[4 + 8 * gi + e];
                    float m1 = -1e30f, m2 = -1e30f; int i1 = 0, i2 = 0;
#pragma unroll
                    for (int e = 0; e < 8; ++e) { if (el[e] > m1) { m2 = m1; i2 = i1; m1 = el[e]; i1 = e; } else if (el[e] > m2) { m2 = el[e]; i2 = e; } }
                    const float e2 = __expf(m2 - m1); const float wa = 1.f / (1.f + e2), wb2 = e2 / (1.f + e2);
                    const int ea = gi * EPG + i1, eb_ = gi * EPG + i2;
                    rt_e[2 * t] = ea; rt_e[2 * t + 1] = eb_;
                    rt_w[2 * t] = ggate * wa; rt_w[2 * t + 1] = ggate * wb2;
                    elist[16 * sb + lane] = ea | (eb_ << 8);
                }
            }
        }
        if (w == 0) {
            if (lane < 32) lcnt[lane] = 0;
            asm volatile("s_waitcnt lgkmcnt(0)" ::: "memory");
            const int ee = elist[lane], ea = ee & 255, eb_ = ee >> 8, t = 64 * tb + lane;
            const int la = (int)__hip_atomic_fetch_add(&lcnt[ea], 1, __ATOMIC_RELAXED, __HIP_MEMORY_SCOPE_WORKGROUP), lb = (int)__hip_atomic_fetch_add(&lcnt[eb_], 1, __ATOMIC_RELAXED, __HIP_MEMORY_SCOPE_WORKGROUP);
            asm volatile("s_waitcnt lgkmcnt(0)" ::: "memory");
            if (lane < 32) { const int c = lcnt[lane]; lcnt[32 + lane] = (c > 0) ? (int)atomicAdd(cnt + lane, (unsigned)c) : 0; }
            asm volatile("s_waitcnt vmcnt(0) lgkmcnt(0)" ::: "memory");
            const int ra = lcnt[32 + ea] + la, rb = lcnt[32 + eb_] + lb;
            rt_rank[2 * t] = ra; rt_rank[2 * t + 1] = rb;
            rowtok[ea * 16384 + ra] = t; rowtok[eb_ * 16384 + rb] = t;
        }
    }
    __syncthreads();
}

__device__ __forceinline__ void phase_final(const Frame& F, const Args& a) {
    float* outp = a.out; const unsigned char* Y = (const unsigned char*)(a.ws + WS_B); const bf16_t* x1b = (const bf16_t*)(a.ws + WS_X1F);
    const float* g2 = a.in[21]; const float* b2 = a.in[22];
    const int* rt_e = (const int*)(a.ws + WS_ROUTE + RT_E); const int* rt_rank = (const int*)(a.ws + WS_ROUTE + RT_RANK); const float* rt_w = (const float*)(a.ws + WS_ROUTE + RT_W);
    const LAS int* toff = (const LAS int*)(F.lds + MISC_OFF);
    const int lane = F.lane;
    typedef float f32x2_ __attribute__((ext_vector_type(2)));
    f32x4 gg[8], bb[8];
#pragma unroll
    for (int j = 0; j < 8; ++j) { const int c = 4 * lane + 256 * j; gg[j] = *(const f32x4*)(g2 + c); bb[j] = *(const f32x4*)(b2 + c); }
    int ne0 = 0, ne1 = 0, nr0 = 0, nr1 = 0; float nw0 = 0.f, nw1 = 0.f;
    if (F.gw < T) { const int t = F.gw; ne0 = rt_e[2 * t]; ne1 = rt_e[2 * t + 1]; nr0 = rt_rank[2 * t]; nr1 = rt_rank[2 * t + 1]; nw0 = rt_w[2 * t]; nw1 = rt_w[2 * t + 1]; }
    for (int t = F.gw; t < T; t += F.ngw) {
        const int p0 = toff[ne0] * 256 + nr0, p1 = toff[ne1] * 256 + nr1;
        const float w0 = nw0 * 0.0625f, w1 = nw1 * 0.0625f;
        { const int tn = t + F.ngw; if (tn < T) { ne0 = rt_e[2 * tn]; ne1 = rt_e[2 * tn + 1]; nr0 = rt_rank[2 * tn]; nr1 = rt_rank[2 * tn + 1]; nw0 = rt_w[2 * tn]; nw1 = rt_w[2 * tn + 1]; } }
        v2u xq[8]; int yq0[8], yq1[8];
#pragma unroll
        for (int j = 0; j < 8; ++j) { const int c = 4 * lane + 256 * j;
            xq[j] = *(const v2u*)(x1b + (size_t)t * D + c); yq0[j] = *(const int*)(Y + (size_t)p0 * D + c); yq1[j] = *(const int*)(Y + (size_t)p1 * D + c); }
        f32x4 v[8]; float s = 0.f; float* xr = outp + (size_t)t * D;
#pragma unroll
        for (int j = 0; j < 8; ++j) { const v2u xb2 = xq[j];
            f32x4 xv; xv.x = __uint_as_float(xb2.x << 16); xv.y = __uint_as_float(xb2.x & 0xffff0000u); xv.z = __uint_as_float(xb2.y << 16); xv.w = __uint_as_float(xb2.y & 0xffff0000u);
            const f32x2_ a0 = __builtin_amdgcn_cvt_pk_f32_fp8(yq0[j], false), a1 = __builtin_amdgcn_cvt_pk_f32_fp8(yq0[j], true);
            const f32x2_ c0 = __builtin_amdgcn_cvt_pk_f32_fp8(yq1[j], false), c1 = __builtin_amdgcn_cvt_pk_f32_fp8(yq1[j], true);
            f32x4 m;
            m.x = w0 * a0.x + w1 * c0.x; m.y = w0 * a0.y + w1 * c0.y; m.z = w0 * a1.x + w1 * c1.x; m.w = w0 * a1.y + w1 * c1.y;
            v[j] = xv * ALPHA + m; s += (v[j].x + v[j].y) + (v[j].z + v[j].w); }
        const float mean = wave_sum(s) * (1.f / D); float s2 = 0.f;
#pragma unroll
        for (int j = 0; j < 8; ++j) { v[j] = v[j] - mean; s2 += (v[j].x * v[j].x + v[j].y * v[j].y) + (v[j].z * v[j].z + v[j].w * v[j].w); }
        const float rstd = 1.f / sqrtf(wave_sum(s2) * (1.f / D) + LN_EPS);
#pragma unroll
        for (int j = 0; j < 8; ++j) { const int c = 4 * lane + 256 * j; *(f32x4*)(xr + c) = v[j] * rstd * gg[j] + bb[j]; }
    }
}


namespace g8 {
typedef short bf16x8 __attribute__((ext_vector_type(8)));
typedef int v8i __attribute__((ext_vector_type(8)));
typedef int v4i __attribute__((ext_vector_type(4)));
constexpr int BM = 256, BK = 64, HALF = 128, HTB = HALF * BK * 2, STAGE_BYTES = 8 * HTB;
__device__ __forceinline__ int lds_byte(int r, int c) { const int st = (r >> 4) * 2 + (c >> 5), rr = r & 15, cc = c & 31, ob = rr * 64 + cc * 2; return st * 1024 + (ob ^ (((ob >> 9) & 1) << 5)); }
__device__ __forceinline__ void stage_rc(int b, int& R, int& C) { const int st = b / 1024, sb = b % 1024, swz = sb ^ (((sb >> 9) & 1) << 5); R = (st >> 1) * 16 + swz / 64; C = (st & 1) * 32 + (swz % 64) / 2; }
__device__ __forceinline__ int perm32(int rho) { const int n = rho >> 4, i = rho & 15; return 8 * (i >> 2) + 4 * n + (i & 3); }
__device__ __forceinline__ unsigned cvt_pk_bf16(float lo, float hi) { unsigned r; asm volatile("v_cvt_pk_bf16_f32 %0, %1, %2" : "=v"(r) : "v"(lo), "v"(hi)); return r; }
struct Unit { int pm, pn, e; };

template <class P, bool SP2 = true>
__device__ __forceinline__ void gemm_phase(LAS unsigned char* lds, const P& prob) {
    const int tid = threadIdx.x, wid = __builtin_amdgcn_readfirstlane(tid >> 6), lane = tid & 63, wr = wid >> 2, wc = wid & 3, fr = lane & 15, fq = lane >> 4;
    constexpr bool F8 = P::FP8;
    constexpr int K = P::K, KB = F8 ? K : 2 * K, nt = KB / 128;
    unsigned voffB[2]; int RA[2]; unsigned CA2[2];
#pragma unroll
    for (int i = 0; i < 2; ++i) { int R, C; stage_rc(tid * 16 + i * 8192, R, C); const int Rb = P::PERM ? ((R & ~31) + perm32(R & 31)) : R;
        RA[i] = R; CA2[i] = (unsigned)C * 2u; voffB[i] = (unsigned)(Rb * KB) + (unsigned)C * 2u; }
    constexpr size_t kstep = (size_t)(BK * 2);
    constexpr size_t hstep = (size_t)HALF * KB;
    const unsigned ldsw = (unsigned)wid * 1024u;
    const int aoff = lds_byte(wr * 64 + fr, F8 ? fq * 16 : fq * 8), boff = lds_byte(wc * 32 + fr, F8 ? fq * 16 : fq * 8);
    constexpr int aoff1 = F8 ? 16 : 1024, boff1 = F8 ? 16 : 1024;
    const char* const Abase = prob.a_base();
#define G8_SA(b, h) (((b) * 2 + (h)) * HTB)
#define G8_SB(b, h) ((4 + (b) * 2 + (h)) * HTB)
#define G8_STAGE_B(bufoff, gbase) do { _Pragma("unroll") for (int _i = 0; _i < 2; ++_i) \
        __builtin_amdgcn_global_load_lds((const unsigned*)((const char*)(gbase) + voffB[_i]), (LAS unsigned*)(lds + (bufoff) + ldsw + _i * 8192), 16, 0, 0); } while (0)
#define G8_STAGE_A(bufoff, kbyte, vo) do { _Pragma("unroll") for (int _i = 0; _i < 2; ++_i) \
        __builtin_amdgcn_global_load_lds((const unsigned*)(Abase + (size_t)(kbyte) + (vo)[_i]), (LAS unsigned*)(lds + (bufoff) + ldsw + _i * 8192), 16, 0, 0); } while (0)
#define G8_LDA(dst, b, h) do { _Pragma("unroll") for (int m = 0; m < 4; ++m) { if constexpr (F8) { const LAS unsigned char* q_ = lds + G8_SA(b, h) + aoff + m * 2048; \
            dst##8[m] = __builtin_shufflevector(*(const LAS v4i*)q_, *(const LAS v4i*)(q_ + aoff1), 0, 1, 2, 3, 4, 5, 6, 7); } \
        else { _Pragma("unroll") for (int k = 0; k < 2; ++k) dst[m][k] = *(const LAS bf16x8*)(lds + G8_SA(b, h) + aoff + m * 2048 + k * aoff1); } } } while (0)
#define G8_LDB(dst, b, h) do { _Pragma("unroll") for (int n = 0; n < 2; ++n) { if constexpr (F8) { const LAS unsigned char* q_ = lds + G8_SB(b, h) + boff + n * 2048; \
            dst##8[n] = __builtin_shufflevector(*(const LAS v4i*)q_, *(const LAS v4i*)(q_ + boff1), 0, 1, 2, 3, 4, 5, 6, 7); } \
        else { _Pragma("unroll") for (int k = 0; k < 2; ++k) dst[n][k] = *(const LAS bf16x8*)(lds + G8_SB(b, h) + boff + n * 2048 + k * boff1); } } } while (0)
#define G8_MMA(ai, bj, At, Bt) do { __builtin_amdgcn_s_setprio(1); _Pragma("unroll") for (int m = 0; m < 4; ++m) _Pragma("unroll") for (int n = 0; n < 2; ++n) { \
        if constexpr (F8) asm volatile("v_mfma_scale_f32_16x16x128_f8f6f4 %0, %1, %2, %0, %3, %4 op_sel_hi:[0,0,0]" : "+v"(acc[ai][bj][m][n]) : "v"(Bt##8[n]), "v"(At##8[m]), "v"(sclB), "v"(sclA)); \
        else { _Pragma("unroll") for (int k = 0; k < 2; ++k) acc[ai][bj][m][n] = __builtin_amdgcn_mfma_f32_16x16x32_bf16(Bt[n][k], At[m][k], acc[ai][bj][m][n], 0, 0, 0); } } \
        __builtin_amdgcn_s_setprio(0); } while (0)
#define G8_WAIT_V(n) asm volatile("s_waitcnt vmcnt(" #n ")" ::: "memory")
#define G8_WAIT_L(n) asm volatile("s_waitcnt lgkmcnt(" #n ")" ::: "memory")
#define G8_BAR __builtin_amdgcn_s_barrier()
#define G8_SCHED __builtin_amdgcn_sched_barrier(0)
    Unit cur, nxt; int ui = 0;
    if (!prob.next(0, cur)) return;
    f32x4 acc[2][2][4][2];
#pragma unroll
    for (int a = 0; a < 2; ++a)
#pragma unroll
        for (int b = 0; b < 2; ++b)
#pragma unroll
            for (int m = 0; m < 4; ++m)
#pragma unroll
                for (int n = 0; n < 2; ++n) acc[a][b][m][n] = (f32x4){0.f, 0.f, 0.f, 0.f};
    bf16x8 At[4][2], B0[2][2], B1[2][2];
    v8i At8[4], B08[2], B18[2];
    const int sclA = P::SCALE_A, sclB = P::SCALE_B;
    unsigned voC[2][2], voN[2][2];
#pragma unroll
    for (int h = 0; h < 2; ++h)
#pragma unroll
        for (int i = 0; i < 2; ++i) voC[h][i] = prob.a_off(cur, h * HALF + RA[i]) + CA2[i];
    const char* cB = prob.b_tile(cur);
    if constexpr (SP2) {
    G8_STAGE_B(G8_SB(0, 0), cB); G8_STAGE_B(G8_SB(0, 1), cB + hstep); G8_STAGE_A(G8_SA(0, 0), 0, voC[0]); G8_STAGE_A(G8_SA(0, 1), 0, voC[1]);
    if (wr == 1) G8_BAR;
    G8_WAIT_V(2); G8_BAR;
    G8_STAGE_B(G8_SB(1, 0), cB + kstep); G8_STAGE_A(G8_SA(1, 0), kstep, voC[0]); G8_STAGE_B(G8_SB(1, 1), cB + hstep + kstep);
    G8_WAIT_V(6); G8_BAR;
    } else {
    G8_STAGE_B(G8_SB(0, 0), cB); G8_STAGE_A(G8_SA(0, 0), 0, voC[0]); G8_STAGE_B(G8_SB(0, 1), cB + hstep); G8_STAGE_A(G8_SA(0, 1), 0, voC[1]);
    if (wr == 1) G8_BAR;
    G8_WAIT_V(4); G8_BAR;
    G8_STAGE_B(G8_SB(1, 0), cB + kstep); G8_STAGE_A(G8_SA(1, 0), kstep, voC[0]); G8_STAGE_B(G8_SB(1, 1), cB + hstep + kstep);
    G8_WAIT_V(6); G8_BAR;
    }
    for (;;) {
        const bool has_next = prob.next(ui + 1, nxt);
        const char* nB = cB;
        if (has_next) {
            nB = prob.b_tile(nxt);
#pragma unroll
            for (int h = 0; h < 2; ++h)
#pragma unroll
                for (int i = 0; i < 2; ++i) voN[h][i] = prob.a_off(nxt, h * HALF + RA[i]) + CA2[i];
        } else {
#pragma unroll
            for (int h = 0; h < 2; ++h)
#pragma unroll
                for (int i = 0; i < 2; ++i) voN[h][i] = voC[h][i];
        }
        for (int t = 0; t < nt; t += 2) {
            const bool last = (t == nt - 2);
            const size_t k1 = (size_t)(t + 1) * kstep;
            const size_t k2 = last ? 0 : (size_t)(t + 2) * kstep, k3 = k2 + kstep;
            const char* b2 = last ? nB : cB + (size_t)(t + 2) * kstep; const char* b3 = b2 + kstep;
            unsigned vo2[2][2];
#pragma unroll
            for (int h = 0; h < 2; ++h)
#pragma unroll
                for (int i = 0; i < 2; ++i) vo2[h][i] = last ? voN[h][i] : voC[h][i];
            if constexpr (SP2) {
            G8_LDB(B0, 0, 0); G8_LDB(B1, 0, 1); G8_SCHED; G8_LDA(At, 0, 0); G8_STAGE_A(G8_SA(1, 1), k1, voC[1]);
            G8_WAIT_V(8); G8_WAIT_L(0); G8_BAR; G8_MMA(0, 0, At, B0); G8_MMA(0, 1, At, B1); G8_BAR; G8_SCHED;
            G8_LDA(At, 0, 1); G8_STAGE_B(G8_SB(0, 0), b2); G8_STAGE_B(G8_SB(0, 1), b2 + hstep); G8_STAGE_A(G8_SA(0, 0), k2, vo2[0]);
            G8_WAIT_V(8); G8_WAIT_L(0); G8_BAR; G8_MMA(1, 0, At, B0); G8_MMA(1, 1, At, B1); G8_BAR; G8_SCHED;
            G8_LDB(B0, 1, 0); G8_LDB(B1, 1, 1); G8_SCHED; G8_LDA(At, 1, 0); G8_STAGE_A(G8_SA(0, 1), k2, vo2[1]);
            G8_WAIT_V(8); G8_WAIT_L(0); G8_BAR; G8_MMA(0, 0, At, B0); G8_MMA(0, 1, At, B1); G8_BAR; G8_SCHED;
            G8_LDA(At, 1, 1); G8_STAGE_B(G8_SB(1, 0), b3); G8_STAGE_B(G8_SB(1, 1), b3 + hstep); G8_STAGE_A(G8_SA(1, 0), k3, vo2[0]);
            G8_WAIT_V(8); G8_WAIT_L(0); G8_BAR; G8_MMA(1, 0, At, B0); G8_MMA(1, 1, At, B1); G8_BAR; G8_SCHED;
            } else {
            G8_LDB(B0, 0, 0); G8_SCHED; G8_LDA(At, 0, 0); G8_STAGE_A(G8_SA(1, 1), k1, voC[1]);
            G8_WAIT_L(8); G8_BAR; G8_WAIT_L(0); G8_MMA(0, 0, At, B0); G8_BAR; G8_SCHED;
            G8_LDB(B1, 0, 1); G8_STAGE_B(G8_SB(0, 0), b2);
            G8_BAR; G8_WAIT_L(0); G8_MMA(0, 1, At, B1); G8_BAR;
            G8_LDA(At, 0, 1); G8_STAGE_A(G8_SA(0, 0), k2, vo2[0]);
            G8_BAR; G8_WAIT_L(0); G8_MMA(1, 0, At, B0); G8_BAR; G8_SCHED;
            G8_STAGE_B(G8_SB(0, 1), b2 + hstep);
            G8_WAIT_V(6); G8_BAR; G8_MMA(1, 1, At, B1); G8_BAR;
            G8_LDB(B0, 1, 0); G8_SCHED; G8_LDA(At, 1, 0); G8_STAGE_A(G8_SA(0, 1), k2, vo2[1]);
            G8_WAIT_L(8); G8_BAR; G8_WAIT_L(0); G8_MMA(0, 0, At, B0); G8_BAR; G8_SCHED;
            G8_LDB(B1, 1, 1); G8_STAGE_B(G8_SB(1, 0), b3);
            G8_BAR; G8_WAIT_L(0); G8_MMA(0, 1, At, B1); G8_BAR;
            G8_LDA(At, 1, 1); G8_STAGE_A(G8_SA(1, 0), k3, vo2[0]);
            G8_BAR; G8_WAIT_L(0); G8_MMA(1, 0, At, B0); G8_BAR; G8_SCHED;
            G8_STAGE_B(G8_SB(1, 1), b3 + hstep);
            G8_WAIT_V(6); G8_BAR; G8_MMA(1, 1, At, B1); G8_BAR;
            }
        }
        if (wr == 0) G8_BAR;
        prob.epi(acc, cur, wr, wc, fr, fq);
        prob.done(cur);
        if (!has_next) break;
#pragma unroll
        for (int a = 0; a < 2; ++a)
#pragma unroll
            for (int b = 0; b < 2; ++b)
#pragma unroll
                for (int m = 0; m < 4; ++m)
#pragma unroll
                    for (int n = 0; n < 2; ++n) acc[a][b][m][n] = (f32x4){0.f, 0.f, 0.f, 0.f};
        cur = nxt; cB = nB; ++ui;
#pragma unroll
        for (int h = 0; h < 2; ++h)
#pragma unroll
            for (int i = 0; i < 2; ++i) voC[h][i] = voN[h][i];
        if (wr == 1) G8_BAR;
    }
    G8_WAIT_V(0);
    G8_BAR;
#undef G8_SA
#undef G8_SB
#undef G8_STAGE_A
#undef G8_STAGE_B
#undef G8_LDA
#undef G8_LDB
#undef G8_MMA
#undef G8_WAIT_V
#undef G8_WAIT_L
#undef G8_BAR
#undef G8_SCHED
}

struct DenseOrder {
    int nM, nN, nwg, G, c, i0, i1;
    __device__ __forceinline__ void init(int M, int N, int G_, int c_) { nM = M / BM; nN = N / BM; nwg = nM * nN; G = G_; c = c_; i0 = 0; i1 = 1 << 30; }
    __device__ __forceinline__ bool next(int i, Unit& u) const {
        if (i + i0 >= i1) return false;
        const long L = (long)(i + i0) * G + c; if (L >= nwg) return false;
        int wgid = (int)L; { const int q = nwg / 8, r = nwg % 8, xcd = wgid % 8, off = wgid / 8; wgid = (xcd < r ? xcd * (q + 1) : r * (q + 1) + (xcd - r) * q) + off; }
        const int nig = 8 * nN, gid = wgid / nig, fm = gid * 8, gsz = (nM - fm) < 8 ? (nM - fm) : 8;
        u.pm = fm + ((wgid % nig) % gsz); u.pn = (wgid % nig) / gsz; u.e = 0; return true;
    }
};

struct ProbProj {
    static constexpr int K = D; static constexpr bool PERM = true, FP8 = false; static constexpr int SCALE_A = 0, SCALE_B = 0;
    const char* A; const char* Bt; bf16_t* C; DenseOrder ord;
    __device__ __forceinline__ bool next(int i, Unit& u) const { return ord.next(i, u); }
    __device__ __forceinline__ void done(const Unit&) const {}
    __device__ __forceinline__ const char* a_base() const { return A; }
    __device__ __forceinline__ unsigned a_off(const Unit& u, int r) const { return (unsigned)(u.pm * BM + r) * (unsigned)(K * 2); }
    __device__ __forceinline__ const char* b_tile(const Unit& u) const { return Bt + (size_t)u.pn * BM * K * 2; }
    __device__ __forceinline__ void epi(const f32x4 (&acc)[2][2][4][2], const Unit& u, int wr, int wc, int fr, int fq) const {
        const int row0 = u.pm * BM + wr * 64 + fr, col0 = u.pn * BM + wc * 32 + 8 * fq;
#pragma unroll
        for (int ai = 0; ai < 2; ++ai)
#pragma unroll
            for (int m = 0; m < 4; ++m) { bf16_t* rowp = C + (size_t)(row0 + ai * HALF + m * 16) * DP + col0;
#pragma unroll
                for (int bj = 0; bj < 2; ++bj) { const f32x4 v0 = acc[ai][bj][m][0], v1 = acc[ai][bj][m][1];
                    v4u w; w.x = cvt_pk_bf16(v0[0], v0[1]); w.y = cvt_pk_bf16(v0[2], v0[3]); w.z = cvt_pk_bf16(v1[0], v1[1]); w.w = cvt_pk_bf16(v1[2], v1[3]);
                    *(v4u*)(rowp + bj * HALF) = w; } }
    }
};
struct ProbOut {
    static constexpr int K = D; static constexpr bool PERM = true, FP8 = false; static constexpr int SCALE_A = 0, SCALE_B = 0;
    const char* A; const char* Bt; bf16_t* C; DenseOrder ord;
    __device__ __forceinline__ bool next(int i, Unit& u) const { return ord.next(i, u); }
    __device__ __forceinline__ void done(const Unit&) const {}
    __device__ __forceinline__ const char* a_base() const { return A; }
    __device__ __forceinline__ unsigned a_off(const Unit& u, int r) const { return (unsigned)(u.pm * BM + r) * (unsigned)(K * 2); }
    __device__ __forceinline__ const char* b_tile(const Unit& u) const { return Bt + (size_t)u.pn * BM * K * 2; }
    __device__ __forceinline__ void epi(const f32x4 (&acc)[2][2][4][2], const Unit& u, int wr, int wc, int fr, int fq) const {
        const int row0 = u.pm * BM + wr * 64 + fr, col0 = u.pn * BM + wc * 32 + 8 * fq;
#pragma unroll
        for (int ai = 0; ai < 2; ++ai)
#pragma unroll
            for (int m = 0; m < 4; ++m) { bf16_t* rowp = C + (size_t)(row0 + ai * HALF + m * 16) * D + col0;
#pragma unroll
                for (int bj = 0; bj < 2; ++bj) { const f32x4 v0 = acc[ai][bj][m][0], v1 = acc[ai][bj][m][1];
                    v4u w; w.x = cvt_pk_bf16(v0[0], v0[1]); w.y = cvt_pk_bf16(v0[2], v0[3]); w.z = cvt_pk_bf16(v1[0], v1[1]); w.w = cvt_pk_bf16(v1[2], v1[3]);
                    *(v4u*)(rowp + bj * HALF) = w; } }
    }
};
struct MoeQueue {
    const LAS int* toff;
    LAS int* slots;
    unsigned* qhead; unsigned* ready; unsigned* tmo;
    template <bool DOWN>
    __device__ __forceinline__ bool claim(int i, Unit& u) const {
        const int NT = toff[NE], U = 4 * NT, DN = 8 * NT;
        if (!DOWN) {
            const int d = (int)blockIdx.x + i * (int)gridDim.x;
            if (d >= U) return false;
            u.pm = d >> 2; u.pn = d & 3;
            const int ln_ = (int)threadIdx.x & 63, myoff = (ln_ < NE) ? toff[ln_] : 0x7fffffff;
            const unsigned long long mk = __builtin_amdgcn_ballot_w64(u.pm >= myoff);
            u.e = __builtin_amdgcn_readfirstlane(63 - (int)__builtin_clzll(mk)); return true;
        }
        if (threadIdx.x == 0) {
            int d; bool polled = false;
            if (slots[3] >= 0) { d = slots[3]; slots[3] = -1; polled = (((d - U) & 7) != 0); }
            else { d = U + (int)__hip_atomic_fetch_add(qhead, 2u, __ATOMIC_RELAXED, __HIP_MEMORY_SCOPE_AGENT); slots[3] = d + 1; }
            if (d < U + DN && !polled) {
                const int rt = (d - U) >> 3; unsigned sp = 0;
                while (__hip_atomic_load(ready + 64 * rt, __ATOMIC_RELAXED, __HIP_MEMORY_SCOPE_AGENT) < 32u) {
                    __builtin_amdgcn_s_sleep(2);
                    if ((++sp & 255u) == 0u) { if (__hip_atomic_load(tmo, __ATOMIC_RELAXED, __HIP_MEMORY_SCOPE_AGENT)) break; if (sp > (1u << 20)) { atomicAdd(tmo, 1u); break; } } }
                __builtin_amdgcn_fence(__ATOMIC_ACQUIRE, "agent");
                asm volatile("s_waitcnt vmcnt(0)" ::: "memory");
            }
            slots[i & 1] = d;
        }
        asm volatile("s_waitcnt lgkmcnt(0)" ::: "memory"); __builtin_amdgcn_s_barrier(); asm volatile("" ::: "memory");
        const int d = __builtin_amdgcn_readfirstlane(slots[i & 1]);
        if (d >= U + DN) return false;
        u.pm = (d - U) >> 3; u.pn = (d - U) & 7;
        const int ln_ = (int)threadIdx.x & 63, myoff = (ln_ < NE) ? toff[ln_] : 0x7fffffff;
        const unsigned long long mk = __builtin_amdgcn_ballot_w64(u.pm >= myoff);
        u.e = __builtin_amdgcn_readfirstlane(63 - (int)__builtin_clzll(mk)); return true;
    }
};
__device__ __forceinline__ void store8_sc1(void* p, v2u v) { asm volatile("global_store_dwordx2 %0, %1, off sc1\n\ts_nop 1" :: "v"(p), "v"(v) : "memory"); }
__device__ __forceinline__ void store16_sc1(void* p, v4u v) { asm volatile("global_store_dwordx4 %0, %1, off sc1\n\ts_nop 1" :: "v"(p), "v"(v) : "memory"); }
struct ProbUp {
    static constexpr int K = D; static constexpr bool PERM = true, FP8 = true;
    static constexpr int SCALE_A = 0x7f7f7f7f, SCALE_B = 0x79797979;
    const char* A; const char* Bt; unsigned char* H; const int* rowtok; MoeQueue q;
    __device__ __forceinline__ bool next(int i, Unit& u) const { return q.claim<false>(i, u); }
    __device__ __forceinline__ void done(const Unit& u) const {
        asm volatile("s_waitcnt vmcnt(0)" ::: "memory");
        if ((threadIdx.x & 63) == 0) __hip_atomic_fetch_add(q.ready + 64 * u.pm, 1u, __ATOMIC_RELAXED, __HIP_MEMORY_SCOPE_AGENT);
    }
    __device__ __forceinline__ const char* a_base() const { return A; }
    __device__ __forceinline__ unsigned a_off(const Unit& u, int r) const { const int rank = (u.pm - q.toff[u.e]) * BM + r; const int tok = (rank < q.toff[64 + u.e]) ? rowtok[u.e * 16384 + rank] : 0; return (unsigned)tok * (unsigned)K; }
    __device__ __forceinline__ const char* b_tile(const Unit& u) const { return Bt + ((size_t)u.e * 1024 + (size_t)u.pn * BM) * K; }
    __device__ __forceinline__ void epi(const f32x4 (&acc)[2][2][4][2], const Unit& u, int wr, int wc, int fr, int fq) const {
        const int row0 = u.pm * BM + wr * 64 + fr, col0 = u.pn * HALF + wc * 32 + 8 * fq;
#pragma unroll
        for (int ai = 0; ai < 2; ++ai)
#pragma unroll
            for (int m = 0; m < 4; ++m) { unsigned char* rowp = H + (size_t)(row0 + ai * HALF + m * 16) * DE + col0;
                float hv[8];
#pragma unroll
                for (int n = 0; n < 2; ++n)
#pragma unroll
                    for (int j = 0; j < 4; ++j) { const float g = acc[ai][0][m][n][j], v = acc[ai][1][m][n][j]; hv[n * 4 + j] = g * __builtin_amdgcn_rcpf(1.f + __expf(-g)) * v; }
                int p0 = 0, p1 = 0;
                p0 = __builtin_amdgcn_cvt_pk_fp8_f32(hv[0], hv[1], p0, false); p0 = __builtin_amdgcn_cvt_pk_fp8_f32(hv[2], hv[3], p0, true);
                p1 = __builtin_amdgcn_cvt_pk_fp8_f32(hv[4], hv[5], p1, false); p1 = __builtin_amdgcn_cvt_pk_fp8_f32(hv[6], hv[7], p1, true);
                store8_sc1(rowp, (v2u){(unsigned)p0, (unsigned)p1}); }
    }
};
struct ProbDown {
    static constexpr int K = DE; static constexpr bool PERM = true, FP8 = true;
    static constexpr int SCALE_A = 0x7f7f7f7f, SCALE_B = 0x7d7d7d7d;
    const char* A; const char* Bt; unsigned char* Y; MoeQueue q;
    __device__ __forceinline__ bool next(int i, Unit& u) const { return q.claim<true>(i, u); }
    __device__ __forceinline__ void done(const Unit&) const {}
    __device__ __forceinline__ const char* a_base() const { return A; }
    __device__ __forceinline__ unsigned a_off(const Unit& u, int r) const { return (unsigned)(u.pm * BM + r) * (unsigned)K; }
    __device__ __forceinline__ const char* b_tile(const Unit& u) const { return Bt + ((size_t)u.e * D + (size_t)u.pn * BM) * K; }
    __device__ __forceinline__ void epi(const f32x4 (&acc)[2][2][4][2], const Unit& u, int wr, int wc, int fr, int fq) const {
        const int row0 = u.pm * BM + wr * 64 + fr, col0 = u.pn * BM + wc * 32 + 8 * fq;
#pragma unroll
        for (int ai = 0; ai < 2; ++ai)
#pragma unroll
            for (int m = 0; m < 4; ++m) { unsigned char* rowp = Y + (size_t)(row0 + ai * HALF + m * 16) * D + col0;
#pragma unroll
                for (int bj = 0; bj < 2; ++bj) { const f32x4 v0 = acc[ai][bj][m][0], v1 = acc[ai][bj][m][1];
                    int p0 = 0, p1 = 0;
                    p0 = __builtin_amdgcn_cvt_pk_fp8_f32(v0[0], v0[1], p0, false); p0 = __builtin_amdgcn_cvt_pk_fp8_f32(v0[2], v0[3], p0, true);
                    p1 = __builtin_amdgcn_cvt_pk_fp8_f32(v1[0], v1[1], p1, false); p1 = __builtin_amdgcn_cvt_pk_fp8_f32(v1[2], v1[3], p1, true);
                    v2u w; w.x = (unsigned)p0; w.y = (unsigned)p1;
                    *(v2u*)(rowp + bj * HALF) = w; } }
    }
};
}


namespace att {
typedef short bf16x8 __attribute__((ext_vector_type(8)));
typedef short s16x4 __attribute__((ext_vector_type(4)));
constexpr int NUNITS = 3 * NBATCH * NH * 32;
constexpr float LOG2E = 1.4426950408889634f, LN2 = 0.6931471805599453f;
__device__ __forceinline__ s16x4 vtr(const LAS unsigned char* p) { return __builtin_bit_cast(s16x4, __builtin_amdgcn_ds_read_tr16_b64_v4i16((LAS s16x4*)p)); }
__device__ __forceinline__ unsigned cvt_pk_bf16(float lo, float hi) { unsigned r; asm volatile("v_cvt_pk_bf16_f32 %0, %1, %2" : "=v"(r) : "v"(lo), "v"(hi)); return r; }

struct UnitA { int p, b, h, r, n, dil; };
__device__ __forceinline__ UnitA decode(int u) {
    UnitA x; x.p = u >> 11; const int rem = u & 2047; x.b = rem >> 9; x.h = (rem >> 5) & 15; const int j = rem & 31;
    x.dil = 1 << (2 * x.p); const int nblk = 32 >> (2 * x.p); x.r = j / nblk; x.n = j % nblk; return x;
}

__device__ __forceinline__ void attn_phase(const Frame& F, const Args& a) {
    const bf16_t* proj = (const bf16_t*)(a.ws + WS_B);
    const int tid = F.tid, lane = F.lane, w = F.wave, i = lane & 15, g = lane >> 4;
    const bool xo = (gridDim.x == 256);
    const int per = xo ? 24 : (NUNITS + (int)gridDim.x - 1) / (int)gridDim.x;
    const int u0 = xo ? 0 : (int)blockIdx.x * per, u1 = xo ? 24 : ((u0 + per < NUNITS) ? (u0 + per) : NUNITS);
    if (u0 >= u1) return;
    const int xcd_ = (int)blockIdx.x & 7, rank_ = (int)blockIdx.x >> 3;
#define ATT_UNIT(k) (xo ? ({ const int s_ = (k) / 3, ul_ = rank_ * 3 + ((k) - 3 * s_), pair_ = xcd_ * 8 + s_; ((ul_ >> 5) << 11) + ((pair_ >> 4) << 9) + ((pair_ & 15) << 5) + (ul_ & 31); }) : (k))
    v4u kst[4], vst[4], qst[2];
    const unsigned kvo0 = (unsigned)(tid >> 3) * (unsigned)(DP * 2), kvo1 = (unsigned)(tid & 7) * 16u;
    const unsigned qvo0 = (unsigned)(16 * w + i) * (unsigned)(DP * 2), qvo1 = (unsigned)g * 16u;
#define ATT_LOAD(U) do { const UnitA x_ = decode(U); const int sh_ = 2 * x_.p; \
        const char* kb_ = (const char*)proj + ((long)x_.b * SEQ + (long)(128 * (x_.n - 1)) * x_.dil + x_.r) * (long)(DP * 2) + (long)((DA + x_.h * HD) * 2); \
        const unsigned vo_ = (kvo0 << sh_) + kvo1; \
        _Pragma("unroll") for (int jj = 0; jj < 4; ++jj) { \
            if (x_.n > 0 || jj >= 2) { const char* kp = kb_ + ((size_t)(64 * jj) * (size_t)(DP * 2) << sh_); kst[jj] = *(const v4u*)(kp + vo_); vst[jj] = *(const v4u*)(kp + vo_ + DA * 2); } \
            else { kst[jj] = (v4u){0u, 0u, 0u, 0u}; vst[jj] = (v4u){0u, 0u, 0u, 0u}; } } \
        { const char* qb_ = (const char*)proj + ((long)x_.b * SEQ + (long)(128 * x_.n) * x_.dil + x_.r) * (long)(DP * 2) + (long)(x_.h * HD * 2); const unsigned qo_ = (qvo0 << sh_) + qvo1; \
          qst[0] = *(const v4u*)(qb_ + qo_); qst[1] = *(const v4u*)(qb_ + qo_ + 64); } } while (0)
    ATT_LOAD(ATT_UNIT(u0));
    const int ts = w & ~1;
    const int kaddr0 = (16 * ts + i) * 128 + (((g) ^ (i & 7)) << 4), kaddr1 = (16 * ts + i) * 128 + (((g + 4) ^ (i & 7)) << 4);
    int vaddr[4];
    { const int q = i >> 2, p_ = i & 3, key = 16 * ts + 4 * g + q, k7 = key & 7;
#pragma unroll
      for (int dt = 0; dt < 4; ++dt) vaddr[dt] = key * 128 + (((2 * dt + (p_ >> 1)) ^ k7) << 4) + (p_ & 1) * 8; }
    bf16x8 qf[2];
#define ATT_STAGE(U_) do { LAS unsigned char* Kw_ = F.lds + (((U_) - u0) & 1) * 65536; \
        _Pragma("unroll") for (int jj = 0; jj < 4; ++jj) { const int cidx = tid + 512 * jj, key = cidx >> 3, ch = cidx & 7; const int la = key * 128 + ((ch ^ (key & 7)) << 4); \
            *(LAS v4u*)(Kw_ + la) = kst[jj]; *(LAS v4u*)(Kw_ + 32768 + la) = vst[jj]; } \
        qf[0] = __builtin_bit_cast(bf16x8, qst[0]); qf[1] = __builtin_bit_cast(bf16x8, qst[1]); } while (0)
    __syncthreads();
    ATT_STAGE(u0);
    __syncthreads();
    if (u0 + 1 < u1) ATT_LOAD(ATT_UNIT(u0 + 1));
    for (int u = u0; u < u1; ++u) {
        const UnitA x = decode(ATT_UNIT(u));
        const LAS unsigned char* Kl = F.lds + ((u - u0) & 1) * 65536; const LAS unsigned char* Vl = Kl + 32768;
        f32x4 S[10];
        {
            bf16x8 ka[2][2], kb[2][2];
#define ATT_LDK(dst, Tt) do { dst[0][0] = *(const LAS bf16x8*)(Kl + kaddr0 + (Tt) * 2048); dst[0][1] = *(const LAS bf16x8*)(Kl + kaddr1 + (Tt) * 2048); \
                              dst[1][0] = *(const LAS bf16x8*)(Kl + kaddr0 + ((Tt) + 1) * 2048); dst[1][1] = *(const LAS bf16x8*)(Kl + kaddr1 + ((Tt) + 1) * 2048); } while (0)
#define ATT_QK(src, Tt) do { f32x4 z0 = (f32x4){0.f, 0.f, 0.f, 0.f}, z1 = z0; \
            z0 = __builtin_amdgcn_mfma_f32_16x16x32_bf16(src[0][0], qf[0], z0, 0, 0, 0); z1 = __builtin_amdgcn_mfma_f32_16x16x32_bf16(src[1][0], qf[0], z1, 0, 0, 0); \
            S[Tt] = __builtin_amdgcn_mfma_f32_16x16x32_bf16(src[0][1], qf[1], z0, 0, 0, 0); S[(Tt) + 1] = __builtin_amdgcn_mfma_f32_16x16x32_bf16(src[1][1], qf[1], z1, 0, 0, 0); } while (0)
            ATT_LDK(ka, 0); ATT_LDK(kb, 2); __builtin_amdgcn_sched_barrier(0);
            ATT_QK(ka, 0); __builtin_amdgcn_sched_barrier(0); ATT_LDK(ka, 4); __builtin_amdgcn_sched_barrier(0);
            ATT_QK(kb, 2); __builtin_amdgcn_sched_barrier(0); ATT_LDK(kb, 6); __builtin_amdgcn_sched_barrier(0);
            ATT_QK(ka, 4); __builtin_amdgcn_sched_barrier(0); ATT_LDK(ka, 8); __builtin_amdgcn_sched_barrier(0);
            ATT_QK(kb, 6); __builtin_amdgcn_sched_barrier(0);
            ATT_QK(ka, 8); __builtin_amdgcn_sched_barrier(0);
#undef ATT_LDK
#undef ATT_QK
        }
        const float slope = exp2f(-0.5f * (float)(x.h + 1));
        const float c1 = 0.125f * LOG2E, c2 = slope * (float)x.dil * LOG2E;
        int dbase = 128 + 16 * w + i - 16 * ts - 4 * g;
        asm volatile("" : "+v"(dbase));
        const float nb = -c2 * (float)dbase;
        float m4[4] = {-INFINITY, -INFINITY, -INFINITY, -INFINITY};
#define ATT_SC_M(Tt, j) do { const int dist = dbase - (16 * (Tt) + (j)); const float tv0 = fmaf(S[Tt][j], c1, fmaf(c2, (float)(16 * (Tt) + (j)), nb)); \
            const float tv = ((unsigned)dist <= (unsigned)dmax) ? tv0 : -INFINITY; S[Tt][j] = tv; m4[j] = fmaxf(m4[j], tv); } while (0)
#define ATT_SC_U(Tt, j) do { const float tv = fmaf(S[Tt][j], c1, fmaf(c2, (float)(16 * (Tt) + (j)), nb)); S[Tt][j] = tv; m4[j] = fmaxf(m4[j], tv); } while (0)
        if (x.n > 0) {
            const int dmax = 128;
#pragma unroll
            for (int Tt = 0; Tt < 10; ++Tt)
#pragma unroll
                for (int j = 0; j < 4; ++j) { if (Tt < 2 || Tt > 7) ATT_SC_M(Tt, j); else ATT_SC_U(Tt, j); }
        } else {
            const int dmax = 16 * w + i;
#pragma unroll
            for (int Tt = 0; Tt < 10; ++Tt)
#pragma unroll
                for (int j = 0; j < 4; ++j) ATT_SC_M(Tt, j);
        }
#undef ATT_SC_M
#undef ATT_SC_U
        float m = fmaxf(fmaxf(m4[0], m4[1]), fmaxf(m4[2], m4[3]));
        m = fmaxf(m, __shfl_xor(m, 16)); m = fmaxf(m, __shfl_xor(m, 32));
        float l4[4] = {0.f, 0.f, 0.f, 0.f};
#pragma unroll
        for (int Tt = 0; Tt < 10; ++Tt)
#pragma unroll
            for (int j = 0; j < 4; ++j) { const float pv = __builtin_amdgcn_exp2f(S[Tt][j] - m); S[Tt][j] = pv; l4[j] += pv; }
        float l = (l4[0] + l4[1]) + (l4[2] + l4[3]);
        l += __shfl_xor(l, 16); l += __shfl_xor(l, 32);
        f32x4 O[4];
#pragma unroll
        for (int dt = 0; dt < 4; ++dt) O[dt] = (f32x4){0.f, 0.f, 0.f, 0.f};
        {
            s16x4 va[4][2], vb[4][2];
#define ATT_LDV(dst, c) do { _Pragma("unroll") for (int dt = 0; dt < 4; ++dt) { dst[dt][0] = vtr(Vl + vaddr[dt] + (c) * 4096); dst[dt][1] = vtr(Vl + vaddr[dt] + (c) * 4096 + 2048); } } while (0)
#define ATT_PV(src, c) do { v4u pw; pw.x = cvt_pk_bf16(S[2 * (c)][0], S[2 * (c)][1]); pw.y = cvt_pk_bf16(S[2 * (c)][2], S[2 * (c)][3]); \
            pw.z = cvt_pk_bf16(S[2 * (c) + 1][0], S[2 * (c) + 1][1]); pw.w = cvt_pk_bf16(S[2 * (c) + 1][2], S[2 * (c) + 1][3]); const bf16x8 pf = __builtin_bit_cast(bf16x8, pw); \
            _Pragma("unroll") for (int dt = 0; dt < 4; ++dt) { const v2u lo_ = __builtin_bit_cast(v2u, src[dt][0]), hi_ = __builtin_bit_cast(v2u, src[dt][1]); const bf16x8 vf = __builtin_bit_cast(bf16x8, ((v4u){lo_.x, lo_.y, hi_.x, hi_.y})); \
                O[dt] = __builtin_amdgcn_mfma_f32_16x16x32_bf16(vf, pf, O[dt], 0, 0, 0); } } while (0)
            ATT_LDV(va, 0); ATT_LDV(vb, 1); __builtin_amdgcn_sched_barrier(0);
            ATT_PV(va, 0); __builtin_amdgcn_sched_barrier(0); ATT_LDV(va, 2); __builtin_amdgcn_sched_barrier(0);
            ATT_PV(vb, 1); __builtin_amdgcn_sched_barrier(0); ATT_LDV(vb, 3); __builtin_amdgcn_sched_barrier(0);
            ATT_PV(va, 2); __builtin_amdgcn_sched_barrier(0); ATT_LDV(va, 4); __builtin_amdgcn_sched_barrier(0);
            ATT_PV(vb, 3); __builtin_amdgcn_sched_barrier(0);
            ATT_PV(va, 4); __builtin_amdgcn_sched_barrier(0);
#undef ATT_LDV
#undef ATT_PV
        }
        const float inv = __builtin_amdgcn_rcpf(l);
        const size_t tq = (size_t)x.b * SEQ + (size_t)(128 * x.n + 16 * w + i) * x.dil + x.r;
        bf16_t* op = (bf16_t*)((unsigned char*)a.out + DO_O + (size_t)x.p * DO_OSTRIDE) + tq * DA + x.h * HD + 4 * g;
#pragma unroll
        for (int dt = 0; dt < 4; ++dt) { v2u o; o.x = cvt_pk_bf16(O[dt][0] * inv, O[dt][1] * inv); o.y = cvt_pk_bf16(O[dt][2] * inv, O[dt][3] * inv); *(v2u*)(op + 16 * dt) = o; }
        if (g == 0) ((float*)(a.ws + WS_LSE))[((size_t)x.p * T + tq) * NH + x.h] = (m + __builtin_amdgcn_logf(l)) * LN2;
        if (u + 1 < u1) ATT_STAGE(u + 1);
        __syncthreads();
        if (u + 2 < u1) ATT_LOAD(ATT_UNIT(u + 2));
    }
#undef ATT_STAGE
#undef ATT_LOAD
#undef ATT_UNIT
}
}


namespace lru {
typedef short bf16x8 __attribute__((ext_vector_type(8)));
constexpr int NUNITS = NBATCH * 16 * 4;
constexpr int CHK = 512, NCHK = SEQ / CHK;
constexpr int OFF_XR = 0, XR_BYTES = (CHK + 4) * 128, OFF_XG = 66560, XG_BYTES = CHK * 32, OFF_WT = OFF_XG + XG_BYTES, OFF_CW = OFF_WT + 2048;
static_assert(XR_BYTES <= OFF_XG && OFF_CW + 16384 <= 131072, "LRU LDS map");
__device__ __forceinline__ unsigned cvt_pk_bf16(float lo, float hi) { unsigned r; asm volatile("v_cvt_pk_bf16_f32 %0, %1, %2" : "=v"(r) : "v"(lo), "v"(hi)); return r; }
__device__ __forceinline__ float sigm(float x) { return __builtin_amdgcn_rcpf(1.f + __expf(-x)); }

__device__ __forceinline__ void lru_phase(const Frame& F, const Args& a) {
    const bf16_t* proj = (const bf16_t*)(a.ws + WS_B);
    const int tid = F.tid, lane = F.lane, w = F.wave, i = lane & 15, g = lane >> 4;
    LAS unsigned char* L = F.lds;
    LAS unsigned char* XR = L + OFF_XR;
    LAS unsigned char* XG = L + OFF_XG;
    for (int uid = blockIdx.x; uid < NUNITS; uid += gridDim.x) {
        const int pair_ = (gridDim.x == 256) ? ((uid & 7) * 8 + (uid >> 5)) : (uid >> 2), q4 = (gridDim.x == 256) ? ((uid >> 3) & 3) : (uid & 3);
        const int b = pair_ >> 4, blk = pair_ & 15;
        const int cblk = blk * 64, ce = cblk + q4 * 16 + i;
        __syncthreads();
        float gbias[2];
        {
            const float* WgA = a.in[4] + (size_t)blk * 64 * 64 + q4 * 16 + i; const float* WgX = a.in[6] + (size_t)blk * 64 * 64 + q4 * 16 + i;
            float wvA[2][8], wvX[2][8]; f32x4 cwq[4][2][2];
#pragma unroll
            for (int ks = 0; ks < 2; ++ks)
#pragma unroll
                for (int j = 0; j < 8; ++j) { wvA[ks][j] = WgA[(8 * g + j + 32 * ks) * 64]; wvX[ks][j] = WgX[(8 * g + j + 32 * ks) * 64]; }
#pragma unroll
            for (int jj = 0; jj < 4; ++jj)
#pragma unroll
                for (int ks = 0; ks < 2; ++ks) { const float* cp = a.in[2] + jj * DL + cblk + 8 * g + 32 * ks; cwq[jj][ks][0] = *(const f32x4*)cp; cwq[jj][ks][1] = *(const f32x4*)(cp + 4); }
#pragma unroll
            for (int ks = 0; ks < 2; ++ks)
#pragma unroll
                for (int jj = 0; jj < 4; ++jj) { v4u pa, px;
#pragma unroll
                    for (int j2 = 0; j2 < 4; ++j2) { const float c0 = cwq[jj][ks][j2 >> 1][(2 * j2) & 3], c1 = cwq[jj][ks][j2 >> 1][(2 * j2 + 1) & 3];
                        pa[j2] = cvt_pk_bf16(c0 * wvA[ks][2 * j2], c1 * wvA[ks][2 * j2 + 1]); px[j2] = cvt_pk_bf16(c0 * wvX[ks][2 * j2], c1 * wvX[ks][2 * j2 + 1]); }
                    if (w == 0) { *(LAS v4u*)(L + OFF_CW + (((0 * 4 + jj) * 2 + ks) * 64 + lane) * 16) = pa; *(LAS v4u*)(L + OFF_CW + (((1 * 4 + jj) * 2 + ks) * 64 + lane) * 16) = px; } }
            float gsA = a.in[5][ce], gsX = a.in[7][ce];
#pragma unroll 1
            for (int d0 = 0; d0 < 64; d0 += 16) { float ta[16], tx[16]; f32x4 cbv[4];
#pragma unroll
                for (int d = 0; d < 16; ++d) { ta[d] = WgA[(d0 + d) * 64]; tx[d] = WgX[(d0 + d) * 64]; }
#pragma unroll
                for (int q = 0; q < 4; ++q) cbv[q] = *(const f32x4*)(a.in[3] + cblk + d0 + 4 * q);
#pragma unroll
                for (int d = 0; d < 16; ++d) { const float cbd = cbv[d >> 2][d & 3]; gsA += cbd * ta[d]; gsX += cbd * tx[d]; } }
            gbias[0] = gsA; gbias[1] = gsX;
        }
        const float cw0 = a.in[2][0 * DL + ce], cw1 = a.in[2][1 * DL + ce], cw2 = a.in[2][2 * DL + ce], cw3 = a.in[2][3 * DL + ce], cb = a.in[3][ce];
        const float bA = gbias[0], bX = gbias[1];
        const float sp8 = 8.0f * log1pf(__expf(-a.in[8][ce]));
        float carry = 0.f;
        v4u sxr[8], sxr8, sxg[2];
        const bf16_t* xrb = proj + (size_t)b * SEQ * DP + 3 * DA + cblk + (tid & 7) * 8;
        const bf16_t* xgb = proj + (size_t)b * SEQ * DP + 3 * DA + DL + cblk + q4 * 16 + (tid & 1) * 8;
#define LRU_LOAD(CH) do { const int t0_ = CHK * (CH) - 4; \
            { int t = t0_ + (tid >> 3); const bool ok = t >= 0; t = ok ? t : 0; sxr[0] = *(const v4u*)(xrb + (size_t)t * DP); if (!ok) sxr[0] = (v4u){0u, 0u, 0u, 0u}; } \
            _Pragma("unroll") for (int k = 1; k < 8; ++k) sxr[k] = *(const v4u*)(xrb + (size_t)(t0_ + 64 * k + (tid >> 3)) * DP); \
            if (tid < 32) sxr8 = *(const v4u*)(xrb + (size_t)(t0_ + 512 + (tid >> 3)) * DP); \
            _Pragma("unroll") for (int k = 0; k < 2; ++k) sxg[k] = *(const v4u*)(xgb + (size_t)(t0_ + 4 + 256 * k + (tid >> 1)) * DP); } while (0)
        LRU_LOAD(0);
        for (int chk = 0; chk < NCHK; ++chk) {
            LAS float* WT = (LAS float*)(L + OFF_WT + (chk & 1) * 1024);
            __syncthreads();
#pragma unroll
            for (int k = 0; k < 8; ++k) { const int rr = 64 * k + (tid >> 3), cc = tid & 7; *(LAS v4u*)(XR + rr * 128 + ((cc ^ (rr & 7)) << 4)) = sxr[k]; }
            if (tid < 32) { const int rr = 512 + (tid >> 3), cc = tid & 7; *(LAS v4u*)(XR + rr * 128 + ((cc ^ (rr & 7)) << 4)) = sxr8; }
#pragma unroll
            for (int k = 0; k < 2; ++k) { const int rr = 256 * k + (tid >> 1), cc = tid & 1; *(LAS v4u*)(XG + rr * 32 + cc * 16) = sxg[k]; }
            __syncthreads();
            if (chk + 1 < NCHK) LRU_LOAD(chk + 1);
            int li = i, lg = g;
            asm volatile("" : "+v"(li), "+v"(lg));
            const int llane = lg * 16 + li;
            float av[4][4], uv[4][4], Ae[4], Be[4], Agt[4], Bgt[4];
#pragma unroll
            for (int gi = 0; gi < 4; ++gi) {
                const int tb = 64 * w + 16 * gi;
                f32x4 ga = (f32x4){0.f, 0.f, 0.f, 0.f}, gx = (f32x4){0.f, 0.f, 0.f, 0.f};
#pragma unroll
                for (int jj = 0; jj < 4; ++jj)
#pragma unroll
                    for (int ks = 0; ks < 2; ++ks) { const int rr = tb + li + 1 + jj, c8 = lg + 4 * ks;
                        const bf16x8 af = *(const LAS bf16x8*)(XR + rr * 128 + ((c8 ^ (rr & 7)) << 4));
                        const bf16x8 wA = *(const LAS bf16x8*)(L + OFF_CW + (((0 * 4 + jj) * 2 + ks) * 64 + llane) * 16), wX = *(const LAS bf16x8*)(L + OFF_CW + (((1 * 4 + jj) * 2 + ks) * 64 + llane) * 16);
                        ga = __builtin_amdgcn_mfma_f32_16x16x32_bf16(af, wA, ga, 0, 0, 0);
                        gx = __builtin_amdgcn_mfma_f32_16x16x32_bf16(af, wX, gx, 0, 0, 0); }
                float r7[7];
                { const int chn = q4 * 16 + li, c8 = chn >> 3, bo = (chn & 7) * 2;
#pragma unroll
                  for (int k = 0; k < 7; ++k) { const int rr = tb + 4 * lg + 1 + k; r7[k] = bf2f(*(const LAS bf16_t*)(XR + rr * 128 + ((c8 ^ (rr & 7)) << 4) + bo)); } }
#pragma unroll
                for (int j = 0; j < 4; ++j) {
                    const float xc = cb + r7[j] * cw0 + r7[j + 1] * cw1 + r7[j + 2] * cw2 + r7[j + 3] * cw3;
                    const float r = sigm(ga[j] + bA), ig = sigm(gx[j] + bX);
                    const float la = -r * sp8;
                    av[gi][j] = __expf(la);
                    uv[gi][j] = __builtin_amdgcn_sqrtf(fmaf(-av[gi][j], av[gi][j], 1.0f)) * (ig * xc);
                }
                float A = av[gi][0], B = uv[gi][0];
#pragma unroll
                for (int j = 1; j < 4; ++j) { B = av[gi][j] * B + uv[gi][j]; A *= av[gi][j]; }
                float Ai = A, Bi = B;
                { const float Ap = __shfl_up(Ai, 16), Bp = __shfl_up(Bi, 16); if (g >= 1) { Bi = Ai * Bp + Bi; Ai = Ai * Ap; } }
                { const float Ap = __shfl_up(Ai, 32), Bp = __shfl_up(Bi, 32); if (g >= 2) { Bi = Ai * Bp + Bi; Ai = Ai * Ap; } }
                Ae[gi] = __shfl_up(Ai, 16); Be[gi] = __shfl_up(Bi, 16); if (g == 0) { Ae[gi] = 1.f; Be[gi] = 0.f; }
                Agt[gi] = __shfl(Ai, 48 + i); Bgt[gi] = __shfl(Bi, 48 + i);
            }
            float Aw_ = Agt[0], Bw_ = Bgt[0];
#pragma unroll
            for (int gi = 1; gi < 4; ++gi) { Bw_ = Agt[gi] * Bw_ + Bgt[gi]; Aw_ *= Agt[gi]; }
            if (g == 0) { WT[(w * 16 + i) * 2] = Aw_; WT[(w * 16 + i) * 2 + 1] = Bw_; }
            __syncthreads();
            float hw = carry, hall = carry;
#pragma unroll
            for (int w2 = 0; w2 < 8; ++w2) { const float Aw = WT[(w2 * 16 + i) * 2], Bw = WT[(w2 * 16 + i) * 2 + 1]; hall = Aw * hall + Bw; if (w2 < w) hw = hall; }
            carry = hall;
            bf16_t* rec = (bf16_t*)((unsigned char*)a.out + DO_REC);
            float hg = hw;
#pragma unroll
            for (int gi = 0; gi < 4; ++gi) {
                float h = Ae[gi] * hg + Be[gi];
#pragma unroll
                for (int j = 0; j < 4; ++j) {
                    h = av[gi][j] * h + uv[gi][j];
                    const int tl = 64 * w + 16 * gi + 4 * lg + j;
                    const float xg = bf2f(*(const LAS bf16_t*)(XG + tl * 32 + li * 2));
                    const float uu = 1.5957691216057308f * (xg + 0.044715f * xg * xg * xg);
                    const float rv = h * xg * sigm(uu);
                    const size_t t = (size_t)b * SEQ + CHK * chk + tl;
                    rec[t * DL + ce] = (bf16_t)f2bf(rv);
                }
                hg = Agt[gi] * hg + Bgt[gi];
            }
        }
#undef LRU_LOAD
    }
}
}

#define XB_TMO      128
#define XB_XCNT(j)  (256  + 64 * (j))
#define XB_XSUB(j)  (1280 + 64 * (j))
#define XB_XGEN(j)  (2304 + 64 * (j))
#define XB_TOP      3328
#define XB_TOPGEN   3392
#define XCD_BAR_WORDS 3456
#define XB_SPIN_CAP (1u << 18)
__device__ __forceinline__ unsigned xb_ld(unsigned* p)              { return __hip_atomic_load(p, __ATOMIC_RELAXED, __HIP_MEMORY_SCOPE_AGENT); }
__device__ __forceinline__ unsigned xb_add(unsigned* p, unsigned v) { return __hip_atomic_fetch_add(p, v, __ATOMIC_RELAXED, __HIP_MEMORY_SCOPE_AGENT); }
__device__ __forceinline__ unsigned xb_xcc_id() { return (unsigned)__builtin_amdgcn_s_getreg((3 << 11) | 20) & 0xFu; }
#define XB_SPIN(cond, bar) do { unsigned _sp = 0; while (cond) { __builtin_amdgcn_s_sleep(1); \
    if ((++_sp & 255u) == 0u) { if (xb_ld(&(bar)[XB_TMO])) break; if (_sp > XB_SPIN_CAP) { atomicAdd(&(bar)[XB_TMO], 1u); break; } } } } while (0)
struct XcdBarrier { unsigned* bar; unsigned x; volatile LAS unsigned* st; };
__device__ __forceinline__ XcdBarrier xcd_barrier_post(unsigned* bar, volatile LAS unsigned* st) {
    XcdBarrier b; b.bar = bar; b.x = xb_xcc_id(); b.st = st;
    if (threadIdx.x == 0) (void)xb_add(&bar[XB_XCNT(b.x)], 1u);
    return b;
}
__device__ __forceinline__ void xcd_barrier_complete(unsigned* bar, unsigned x, unsigned& nloc, unsigned& nx) {
    const unsigned G = gridDim.x * gridDim.y * gridDim.z;
    unsigned sum, cnt, mine, sp = 0u;
    for (;;) {
        sum = 0u; cnt = 0u; mine = 0u;
#pragma unroll
        for (unsigned j = 0; j < 16; ++j) { const unsigned c = xb_ld(&bar[XB_XCNT(j)]); sum += c; cnt += (c > 0u) ? 1u : 0u; mine = (j == x) ? c : mine; }
        if (sum == G) break;
        __builtin_amdgcn_s_sleep(1);
        if ((++sp & 255u) == 0u) { if (xb_ld(&bar[XB_TMO])) break; if (sp > XB_SPIN_CAP) { atomicAdd(&bar[XB_TMO], 1u); break; } }
    }
    nloc = mine > 0u ? mine : 1u; nx = cnt > 0u ? cnt : 1u;
}
__device__ __forceinline__ void xcd_barrier(const XcdBarrier& b) {
    asm volatile("s_waitcnt vmcnt(0)" ::: "memory");
    __syncthreads();
    if (threadIdx.x == 0) {
        unsigned* bar = b.bar;
        __builtin_amdgcn_s_waitcnt(0);
        unsigned nloc = b.st[0], nx = b.st[1];
        if (nloc == 0u) { xcd_barrier_complete(bar, b.x, nloc, nx); b.st[0] = nloc; b.st[1] = nx; }
        const unsigned old = xb_add(&bar[XB_XSUB(b.x)], 1u);
        const unsigned gen = old / nloc;
        if (old + 1u == (gen + 1u) * nloc) {
            __builtin_amdgcn_fence(__ATOMIC_RELEASE, "agent");
            asm volatile("s_waitcnt vmcnt(0)" ::: "memory");
            const unsigned og = xb_add(&bar[XB_TOP], 1u);
            const unsigned tg = og / nx;
            if (og + 1u == (tg + 1u) * nx) xb_add(&bar[XB_TOPGEN], 1u);
            else XB_SPIN(xb_ld(&bar[XB_TOPGEN]) == tg, bar);
            __builtin_amdgcn_fence(__ATOMIC_ACQUIRE, "agent");
            xb_add(&bar[XB_XGEN(b.x)], 1u);
            asm volatile("s_waitcnt vmcnt(0)" ::: "memory");
        } else {
            XB_SPIN(xb_ld(&bar[XB_XGEN(b.x)]) == gen, bar);
            __builtin_amdgcn_fence(__ATOMIC_ACQUIRE, "agent");
            asm volatile("s_waitcnt vmcnt(0)" ::: "memory");
        }
    }
    __syncthreads();
}

#ifndef PROBE_PH
#define PROBE_PH -1
#endif
#define NREP(k) (((k) == PROBE_PH) ? 3 : 1)
#ifndef UP_SP2
#define UP_SP2 true
#endif
enum Phase { PH_CONVERT = 0, PH_GEMM1, PH_ATTN_LRU, PH_COMBINE, PH_GEMM2, PH_LN1, PH_MOE, PH_FINAL, PH_N };


__global__ void __launch_bounds__(NTHR, 2) mega(Args args) {
    extern __shared__ __attribute__((aligned(16))) unsigned char lds[];
    Frame F; F.lds = (LAS unsigned char*)lds; F.tid = threadIdx.x; F.lane = F.tid & 63; F.wave = __builtin_amdgcn_readfirstlane(F.tid >> 6);
    F.gw = blockIdx.x * NWAVES + F.wave; F.ngw = gridDim.x * NWAVES;
#define FRAME(Fn) Frame Fn; { int t_ = threadIdx.x; asm volatile("" : "+v"(t_)); Fn.lds = (LAS unsigned char*)lds; Fn.tid = t_; Fn.lane = t_ & 63; Fn.wave = __builtin_amdgcn_readfirstlane(t_ >> 6); \
        Fn.gw = blockIdx.x * NWAVES + Fn.wave; Fn.ngw = gridDim.x * NWAVES; }
    const int lo = args.lo, hi = args.hi;
    volatile LAS unsigned* bst = (volatile LAS unsigned*)(F.lds + BARST_OFF);
    if (F.tid < 4) bst[F.tid] = 0u;
    __syncthreads();
    XcdBarrier bar; bar.bar = (unsigned*)(args.ws + WS_CTL) + CW_BAR; bar.x = 0; bar.st = bst;
    if (hi - lo > 1) bar = xcd_barrier_post((unsigned*)(args.ws + WS_CTL) + CW_BAR, bst);
#define IN(k) (lo <= (k) && (k) < hi)
#define SEAM(k) do { if (IN(k) && IN((k) + 1)) xcd_barrier(bar); } while (0)
    if (IN(PH_CONVERT)) phase_convert(F, args);
    SEAM(PH_CONVERT);
    if (IN(PH_GEMM1)) {
        const int cls = ((int)blockIdx.x >> 3) & 3, ks = (cls == 0) ? 0 : (cls == 1 ? 1 : (cls == 2 ? 3 : (1 << 29)));
        g8::ProbProj P; P.A = (const char*)(args.ws + WS_D); P.Bt = (const char*)(args.ws + WS_WIN); P.C = (bf16_t*)(args.ws + WS_B); P.ord.init(T, DP, gridDim.x, blockIdx.x);
        P.ord.i0 = 0; P.ord.i1 = ks;
        g8::gemm_phase(F.lds, P);
        __syncthreads();
        convert_rest(F, args);
        __syncthreads();
        P.ord.i0 = ks; P.ord.i1 = 1 << 30;
        g8::gemm_phase(F.lds, P);
    }
    SEAM(PH_GEMM1);
    if (IN(PH_ATTN_LRU)) { lru::lru_phase(F, args); att::attn_phase(F, args); }
    SEAM(PH_ATTN_LRU);
    if (IN(PH_COMBINE)) phase_combine(F, args);
    SEAM(PH_COMBINE);
#define DO_GEMM2() {         g8::ProbOut P; P.A = (const char*)(args.ws + WS_Y); P.Bt = (const char*)(args.ws + WS_WOUT); P.C = (bf16_t*)(args.ws + WS_B); P.ord.init(T, D, gridDim.x, blockIdx.x);         g8::gemm_phase(F.lds, P);     }
    if (IN(PH_GEMM2)) { DO_GEMM2(); if (NREP(PH_GEMM2) > 1) { DO_GEMM2(); DO_GEMM2(); } }
    SEAM(PH_GEMM2);
    if (IN(PH_LN1)) phase_ln1_router(F, args);
    SEAM(PH_LN1);
    if (IN(PH_MOE) || IN(PH_FINAL)) {
        LAS int* toff = (LAS int*)(F.lds + MISC_OFF);
        const unsigned* cnt = (const unsigned*)(args.ws + WS_CTL) + CW_CNT;
        if (F.tid == 0) { int acc = 0; for (int e = 0; e < NE; ++e) { const int c = (int)cnt[e]; toff[e] = acc; toff[64 + e] = c; acc += (c + 255) >> 8; } toff[NE] = acc; toff[128 + 3] = -1; }
        __syncthreads();
    }
    if (IN(PH_MOE)) {
        g8::MoeQueue Q; Q.toff = (const LAS int*)(F.lds + MISC_OFF); Q.slots = (LAS int*)(F.lds + MISC_OFF + 512);
        Q.qhead = (unsigned*)(args.ws + WS_CTL) + CW_QHEAD; Q.ready = (unsigned*)(args.ws + WS_CTL) + CW_READY; Q.tmo = (unsigned*)(args.ws + WS_CTL) + CW_BAR + XB_TMO;
        {
            g8::ProbUp P; P.A = (const char*)(args.ws + WS_X8); P.Bt = (const char*)(args.ws + WS_W13); P.H = (unsigned char*)(args.ws + WS_D); P.rowtok = (const int*)(args.ws + WS_ROUTE + RT_ROWTOK); P.q = Q;
            g8::gemm_phase<g8::ProbUp, UP_SP2>(F.lds, P);
        }
        {
            g8::ProbDown P; P.A = (const char*)(args.ws + WS_D); P.Bt = (const char*)(args.ws + WS_W2); P.Y = (unsigned char*)(args.ws + WS_B); P.q = Q;
            g8::gemm_phase(F.lds, P);
        }
    }
    SEAM(PH_MOE);
    if (IN(PH_FINAL)) phase_final(F, args);
#undef IN
#undef SEAM
}

extern "C" void kernel_launch(void* const* d_in, const int* in_sizes, int n_in, void* d_out, int out_size, void* d_ws, size_t ws_size, hipStream_t stream) {
    static int grid = 0;
    if (grid == 0) {
        if (n_in != 23 || out_size != T * D || ws_size < WS_END) { fprintf(stderr, "kernel_launch: unexpected shapes (n_in %d out %d ws %zu)\n", n_in, out_size, ws_size); grid = -1; return; }
        int dev = 0, cus = 0;
        if (hipGetDevice(&dev) != hipSuccess || hipDeviceGetAttribute(&cus, hipDeviceAttributeMultiprocessorCount, dev) != hipSuccess) { grid = -1; return; }
        if (hipFuncSetAttribute((const void*)mega, hipFuncAttributeMaxDynamicSharedMemorySize, LDS_BYTES) != hipSuccess) { grid = -1; return; }
        grid = cus;
    }
    if (grid < 0) return;
    (void)in_sizes;
    hipMemsetAsync((char*)d_ws + WS_CTL, 0, CTL_BYTES, stream);
    Args a{};
    for (int i = 0; i < 23; ++i) a.in[i] = (const float*)d_in[i];
    a.out = (float*)d_out; a.ws = (unsigned char*)d_ws; a.lo = 0; a.hi = 0;
    auto run = [&](int lo, int hi) { a.lo = lo; a.hi = hi; hipLaunchKernelGGL(mega, dim3(grid), dim3(NTHR), LDS_BYTES, stream, a); };
#if defined(MK_PER_PHASE)
    for (int ph = 0; ph < PH_N; ++ph) run(ph, ph + 1);
#else
    run(0, PH_N);
#endif
}
```

```cpp
#include <hip/hip_runtime.h>
#include <stdint.h>
#include <stdio.h>

#define GAS __attribute__((address_space(1)))
#define LAS __attribute__((address_space(3)))
typedef unsigned short bf16_t;
typedef unsigned v4u __attribute__((ext_vector_type(4)));
typedef unsigned v2u __attribute__((ext_vector_type(2)));
typedef float f32x4 __attribute__((ext_vector_type(4)));

constexpr int T = 16384, SEQ = 4096, NBATCH = 4, D = 2048, DP = 5120, DA = 1024, DL = 1024, NH = 16, HD = 64;
constexpr int NE = 32, DE = 512, NGRP = 4, EPG = 8;
constexpr int PMAX = 40960;
constexpr float ALPHA = 1.189207115002721f;
constexpr float LN_EPS = 1e-5f, RMS_EPS = 1e-6f;
constexpr int NWAVES = 8, NTHR = 512;
constexpr int LDS_BYTES = 163840, MISC_OFF = 131072 + 1024, BARST_OFF = 131072 + 2048;

constexpr size_t MiB = 1u << 20;
constexpr size_t WS_CTL = 0, CTL_BYTES = 1 * MiB;
constexpr size_t WS_WIN = 1 * MiB;
constexpr size_t WS_WOUT = 21 * MiB;
constexpr size_t WS_W13 = 29 * MiB;
constexpr size_t WS_Y = 93 * MiB;
constexpr size_t WS_W2 = 157 * MiB;
constexpr size_t WS_B = 221 * MiB;
constexpr size_t WS_X1B_OFF = 64 * MiB;
constexpr size_t WS_D = 381 * MiB;
constexpr size_t WS_LSE = 445 * MiB;
constexpr size_t WS_SSQR = 448 * MiB;
constexpr size_t WS_ROUTE = 452 * MiB;
constexpr size_t WS_X1F = 456 * MiB;
constexpr size_t WS_X8 = 520 * MiB;
constexpr size_t WS_END = 552 * MiB;
constexpr size_t RT_E = 0;
constexpr size_t RT_W = 131072;
constexpr size_t RT_RANK = 262144;
constexpr size_t RT_POS = 393216;
constexpr size_t RT_ROWTOK = 2097152;
constexpr size_t RT_WR = 1048576;
constexpr int CW_CNT = 64;
constexpr int CW_BAR = 4096;
constexpr int CW_QHEAD = 128;
constexpr int CW_READY = 8192;

constexpr size_t DO_O = 0, DO_OSTRIDE = (size_t)T * DA * 2, DO_REC = 3 * DO_OSTRIDE;

__device__ __forceinline__ float bf2f(bf16_t b) { return __uint_as_float(((unsigned)b) << 16); }
__device__ __forceinline__ unsigned f2bf(float f) { unsigned u = __float_as_uint(f); return (u + 0x7fffu + ((u >> 16) & 1u)) >> 16; }
__device__ __forceinline__ unsigned pk2(float lo, float hi) { unsigned r; asm("v_cvt_pk_bf16_f32 %0, %1, %2" : "=v"(r) : "v"(lo), "v"(hi)); return r; }
__device__ __forceinline__ float wave_sum(float v) {
#pragma unroll
    for (int o = 1; o < 64; o <<= 1) v += __shfl_xor(v, o);
    return v;
}
__device__ __forceinline__ float sigmoidf_(float x) { return 1.f / (1.f + __expf(-x)); }
__device__ __forceinline__ float gelu_tanh(float x) { const float u = 0.7978845608028654f * (x + 0.044715f * x * x * x); return 0.5f * x * (1.f + tanhf(u)); }

struct Args {
    const float* in[23];
    float* out;
    unsigned char* ws;
    int lo, hi;
};

struct Frame {
    LAS unsigned char* lds;
    int tid, lane, wave, gw, ngw;
};

__device__ __forceinline__ void transpose_item(const float* W, int K, int N, bf16_t* WT, int mode, LAS unsigned char* scr, int item, int lane, bool nts = false) {
    const int kblk = K / 64, nb = item / kblk, kb = item - nb * kblk, k0 = 64 * kb, n0 = 64 * nb;
    int drow0 = n0;
    if (mode == 1) drow0 = (n0 / 128) * 256 + (n0 % 128);
    if (mode == 2) drow0 = (n0 / 128) * 256 + 128 + (n0 % 128);
    const int r4 = lane >> 4, c = lane & 15;
    f32x4 v[16];
    const float* src = W + (size_t)(k0 + 2 * r4) * N + n0 + 4 * c;
#pragma unroll
    for (int j = 0; j < 8; ++j) { v[2 * j] = __builtin_nontemporal_load((const f32x4*)(src + (size_t)(8 * j) * N)); v[2 * j + 1] = __builtin_nontemporal_load((const f32x4*)(src + (size_t)(8 * j + 1) * N)); }
#pragma unroll
    for (int j = 0; j < 8; ++j)
#pragma unroll
        for (int q = 0; q < 4; ++q) { const int n = 4 * c + q;
            *(LAS unsigned*)(scr + n * 128 + ((j ^ (c & 7)) << 4) + 4 * r4) = pk2(v[2 * j][q], v[2 * j + 1][q]); }
    asm volatile("s_waitcnt lgkmcnt(0)" ::: "memory");
    const int ch = lane & 7;
#pragma unroll
    for (int j = 0; j < 8; ++j) { const int n = 8 * j + (lane >> 3);
        const v4u o = *(const LAS v4u*)(scr + n * 128 + ((ch ^ ((n >> 2) & 7)) << 4));
        v4u* dp_ = (v4u*)(WT + (size_t)(drow0 + n) * K + k0 + 8 * ch); if (nts) __builtin_nontemporal_store(o, dp_); else *dp_ = o; }
    asm volatile("s_waitcnt lgkmcnt(0)" ::: "memory");
}

__device__ __forceinline__ void phase_convert(const Frame& F, const Args& a) {
    unsigned char* ws = a.ws;
    {
        const float* x = a.in[0]; bf16_t* xb = (bf16_t*)(ws + WS_D);
        const size_t nch = (size_t)T * D / 8;
        for (size_t i = (size_t)F.gw * 256 + F.lane; i < nch; i += (size_t)F.ngw * 256) {
            f32x4 v0[4], v1[4];
#pragma unroll
            for (int q = 0; q < 4; ++q) { v0[q] = __builtin_nontemporal_load((const f32x4*)(x + (i + 64 * q) * 8)); v1[q] = __builtin_nontemporal_load((const f32x4*)(x + (i + 64 * q) * 8 + 4)); }
#pragma unroll
            for (int q = 0; q < 4; ++q) { v4u o; o.x = pk2(v0[q].x, v0[q].y); o.y = pk2(v0[q].z, v0[q].w); o.z = pk2(v1[q].x, v1[q].y); o.w = pk2(v1[q].z, v1[q].w);
                *(v4u*)(xb + (i + 64 * q) * 8) = o; }
        }
    }
    {
        bf16_t* WrT = (bf16_t*)(ws + WS_ROUTE + RT_WR);
        for (int idx = F.gw * 64 + F.lane; idx < 48 * D; idx += F.ngw * 64) {
            const int j = idx & 7, ln = (idx >> 3) & 63, blk = idx >> 9;
            const int nt = blk % 3, wk = blk / 3, col = 16 * nt + (ln & 15), k = 32 * wk + 8 * (ln >> 4) + j;
            const float wv = (col < 4) ? a.in[14][k * NGRP + col] : ((col < 36) ? a.in[16][k * NE + (col - 4)] : 0.f);
            const unsigned hb = pk2(wv, 0.f) & 0xffffu; const float hf = __uint_as_float(hb << 16);
            WrT[(size_t)(2 * blk) * 512 + ln * 8 + j] = (bf16_t)hb; WrT[(size_t)(2 * blk + 1) * 512 + ln * 8 + j] = (bf16_t)(pk2(wv - hf, 0.f) & 0xffffu); }
    }
    LAS unsigned char* scr = F.lds + F.wave * 8192;
    constexpr int I_IN = (D / 64) * (DP / 64);
    { const int run = (I_IN + F.ngw - 1) / F.ngw; for (int r = 0; r < run; ++r) { const int it = F.gw * run + r; if (it < I_IN) transpose_item(a.in[1], D, DP, (bf16_t*)(ws + WS_WIN), 0, scr, it, F.lane); } }
}
__device__ __forceinline__ void transpose_item8(const float* W, int K, int N, unsigned char* WT, int mode, LAS unsigned char* scr, int item, int lane, bool nts = false) {
    const int kblk = K / 64, nb = item / kblk, kb = item - nb * kblk, k0 = 64 * kb, n0 = 64 * nb;
    int drow0 = n0;
    if (mode == 1) drow0 = (n0 / 128) * 256 + (n0 % 128);
    if (mode == 2) drow0 = (n0 / 128) * 256 + 128 + (n0 % 128);
    const int r4 = lane >> 4, c = lane & 15;
    f32x4 v[16];
    const float* src = W + (size_t)(k0 + 4 * r4) * N + n0 + 4 * c;
#pragma unroll
    for (int j = 0; j < 4; ++j)
#pragma unroll
        for (int s4 = 0; s4 < 4; ++s4) v[4 * j + s4] = __builtin_nontemporal_load((const f32x4*)(src + (size_t)(16 * j + s4) * N));
#pragma unroll
    for (int j = 0; j < 4; ++j)
#pragma unroll
        for (int q = 0; q < 4; ++q) { const int n = 4 * c + q;
            int pk = 0;
            pk = __builtin_amdgcn_cvt_pk_fp8_f32(v[4 * j][q] * 64.f, v[4 * j + 1][q] * 64.f, pk, false);
            pk = __builtin_amdgcn_cvt_pk_fp8_f32(v[4 * j + 2][q] * 64.f, v[4 * j + 3][q] * 64.f, pk, true);
            *(LAS int*)(scr + n * 64 + ((j ^ (c & 3)) << 4) + 4 * r4) = pk; }
    asm volatile("s_waitcnt lgkmcnt(0)" ::: "memory");
    const int pch = lane & 3;
#pragma unroll
    for (int j = 0; j < 4; ++j) { const int n = 16 * j + (lane >> 2);
        const v4u o = *(const LAS v4u*)(scr + n * 64 + ((pch ^ ((n >> 2) & 3)) << 4));
        v4u* dp_ = (v4u*)(WT + (size_t)(drow0 + n) * K + k0 + 16 * pch); if (nts) __builtin_nontemporal_store(o, dp_); else *dp_ = o; }
    asm volatile("s_waitcnt lgkmcnt(0)" ::: "memory");
}
__device__ __forceinline__ void convert_rest(const Frame& F, const Args& a) {
    unsigned char* ws = a.ws;
    LAS unsigned char* scr = F.lds + F.wave * 8192;
    constexpr int I_OUT = (D / 64) * (D / 64), I_E13 = (D / 64) * (DE / 64), I_E2 = (DE / 64) * (D / 64);
    constexpr int NITEMS = I_OUT + NE * (2 * I_E13 + I_E2);
    const int run_ = (NITEMS + F.ngw - 1) / F.ngw;
    for (int rr_ = 0; rr_ < run_; ++rr_) {
        const int it = F.gw * run_ + rr_; if (it >= NITEMS) break;
        int r = it;
        if (r < I_OUT) { transpose_item(a.in[11], D, D, (bf16_t*)(ws + WS_WOUT), 0, scr, r, F.lane, true); continue; } r -= I_OUT;
        const int per_e = 2 * I_E13 + I_E2, e = r / per_e; r -= e * per_e;
        if (r < I_E13) { transpose_item8(a.in[18] + (size_t)e * D * DE, D, DE, (unsigned char*)(ws + WS_W13) + (size_t)e * 1024 * D, 1, scr, r, F.lane, true); continue; } r -= I_E13;
        if (r < I_E13) { transpose_item8(a.in[19] + (size_t)e * D * DE, D, DE, (unsigned char*)(ws + WS_W13) + (size_t)e * 1024 * D, 2, scr, r, F.lane, true); continue; } r -= I_E13;
        transpose_item8(a.in[20] + (size_t)e * DE * D, DE, D, (unsigned char*)(ws + WS_W2) + (size_t)e * D * DE, 0, scr, r, F.lane, true);
    }
}

__device__ __forceinline__ void phase_combine(const Frame& F, const Args& a) {
    const unsigned char* dob = (const unsigned char*)a.out;
    const float* lse = (const float*)(a.ws + WS_LSE);
    bf16_t* y = (bf16_t*)(a.ws + WS_Y);
    const int lane = F.lane, h = lane >> 2;
    float gav[16], grv[16];
#pragma unroll
    for (int j = 0; j < 4; ++j) { const f32x4 ta = *(const f32x4*)(a.in[9] + 16 * lane + 4 * j), tr = *(const f32x4*)(a.in[10] + 16 * lane + 4 * j);
        gav[4 * j] = ta.x; gav[4 * j + 1] = ta.y; gav[4 * j + 2] = ta.z; gav[4 * j + 3] = ta.w; grv[4 * j] = tr.x; grv[4 * j + 1] = tr.y; grv[4 * j + 2] = tr.z; grv[4 * j + 3] = tr.w; }
    for (int t = F.gw; t < T; t += F.ngw) {
        const float l0 = lse[(size_t)(0 * T + t) * NH + h], l1 = lse[(size_t)(1 * T + t) * NH + h], l2 = lse[(size_t)(2 * T + t) * NH + h];
        v4u oa[3][2], rr[2];
#pragma unroll
        for (int pp = 0; pp < 3; ++pp) { const v4u* po = (const v4u*)(dob + DO_O + (size_t)pp * DO_OSTRIDE + ((size_t)t * DA + 16 * lane) * 2); oa[pp][0] = __builtin_nontemporal_load(po); oa[pp][1] = __builtin_nontemporal_load(po + 1); }
        { const v4u* pr = (const v4u*)(dob + DO_REC + ((size_t)t * DL + 16 * lane) * 2); rr[0] = __builtin_nontemporal_load(pr); rr[1] = __builtin_nontemporal_load(pr + 1); }
        const float mx = fmaxf(l0, fmaxf(l1, l2));
        float w0 = __expf(l0 - mx), w1 = __expf(l1 - mx), w2 = __expf(l2 - mx);
        const float inv = 1.f / (w0 + w1 + w2); w0 *= inv; w1 *= inv; w2 *= inv;
        float v[16], rv[16]; float ss = 0.f, sr = 0.f;
#pragma unroll
        for (int q = 0; q < 2; ++q)
#pragma unroll
            for (int j = 0; j < 4; ++j) {
                const unsigned u0 = oa[0][q][j], u1 = oa[1][q][j], u2 = oa[2][q][j], ur = rr[q][j];
                const float lo = w0 * __uint_as_float(u0 << 16) + w1 * __uint_as_float(u1 << 16) + w2 * __uint_as_float(u2 << 16);
                const float hi = w0 * __uint_as_float(u0 & 0xffff0000u) + w1 * __uint_as_float(u1 & 0xffff0000u) + w2 * __uint_as_float(u2 & 0xffff0000u);
                v[q * 8 + 2 * j] = lo; v[q * 8 + 2 * j + 1] = hi; ss += lo * lo + hi * hi;
                const float rl = __uint_as_float(ur << 16), rh = __uint_as_float(ur & 0xffff0000u);
                rv[q * 8 + 2 * j] = rl; rv[q * 8 + 2 * j + 1] = rh; sr += rl * rl + rh * rh;
            }
        ss = wave_sum(ss); sr = wave_sum(sr);
        const float rsa = 1.f / sqrtf(ss * (1.f / DA) + RMS_EPS), rsr = 1.f / sqrtf(sr * (1.f / DL) + RMS_EPS);
        v4u o[2], o2[2];
#pragma unroll
        for (int q = 0; q < 2; ++q)
#pragma unroll
            for (int j = 0; j < 4; ++j) { const int c = q * 8 + 2 * j;
                o[q][j] = pk2(v[c] * rsa * gav[c], v[c + 1] * rsa * gav[c + 1]); o2[q][j] = pk2(rv[c] * rsr * grv[c], rv[c + 1] * rsr * grv[c + 1]); }
        { v4u* dst = (v4u*)(y + (size_t)t * D + 16 * lane); dst[0] = o[0]; dst[1] = o[1]; }
        { v4u* dst = (v4u*)(y + (size_t)t * D + DA + 16 * lane); dst[0] = o2[0]; dst[1] = o2[1]; }
    }
}

constexpr int LN1_ROW = 8208;
__device__ __forceinline__ void phase_ln1_router(const Frame& F, const Args& a) {
    bf16_t* x1b = (bf16_t*)(a.ws + WS_X1F); unsigned char* x1f8 = (unsigned char*)(a.ws + WS_X8); const bf16_t* mixb = (const bf16_t*)(a.ws + WS_B); const bf16_t* xbb = (const bf16_t*)(a.ws + WS_D);
    const float* g1 = a.in[12]; const float* b1 = a.in[13];
    const float* gb = a.in[15]; const float* eb = a.in[17];
    const bf16_t* WrT = (const bf16_t*)(a.ws + WS_ROUTE + RT_WR);
    int* rt_e = (int*)(a.ws + WS_ROUTE + RT_E); float* rt_w = (float*)(a.ws + WS_ROUTE + RT_W); int* rt_rank = (int*)(a.ws + WS_ROUTE + RT_RANK);
    unsigned* cnt = (unsigned*)(a.ws + WS_CTL) + CW_CNT; int* rowtok = (int*)(a.ws + WS_ROUTE + RT_ROWTOK);
    const int lane = F.lane, i = lane & 15, g = lane >> 4, w = F.wave;
    LAS unsigned char* L = F.lds;
    LAS float* rbias = (LAS float*)(F.lds + 131072 + 3072);
    if (F.tid < 48) rbias[F.tid] = (F.tid < 4) ? gb[F.tid] : ((F.tid < 36) ? eb[F.tid - 4] : 0.f);
    LAS int* elist = (LAS int*)(F.lds + 131072 + 3584); LAS int* lcnt = elist + 64;
    LAS unsigned char* PT = F.lds + 131072 + 5120;
    for (int tb = blockIdx.x; tb < T / 64; tb += gridDim.x) {
        __syncthreads();
#pragma unroll 1
        for (int sb = 0; sb < 4; ++sb) {
            v2u xv2[2][8], mv2[2][8];
#pragma unroll
            for (int q = 0; q < 2; ++q)
#pragma unroll
                for (int j = 0; j < 8; ++j) { const size_t o = (size_t)(64 * tb + 16 * sb + 2 * w + q) * D + 4 * lane + 256 * j; xv2[q][j] = __builtin_nontemporal_load((const v2u*)(xbb + o)); mv2[q][j] = __builtin_nontemporal_load((const v2u*)(mixb + o)); }
#pragma unroll
            for (int q = 0; q < 2; ++q) {
                const int tl = 2 * w + q, t = 64 * tb + 16 * sb + tl;
                f32x4 v[8]; float s = 0.f;
#pragma unroll
                for (int j = 0; j < 8; ++j) { const v2u xq = xv2[q][j]; const v2u mq = mv2[q][j];
                    v[j].x = ALPHA * __uint_as_float(xq.x << 16) + __uint_as_float(mq.x << 16); v[j].y = ALPHA * __uint_as_float(xq.x & 0xffff0000u) + __uint_as_float(mq.x & 0xffff0000u);
                    v[j].z = ALPHA * __uint_as_float(xq.y << 16) + __uint_as_float(mq.y << 16); v[j].w = ALPHA * __uint_as_float(xq.y & 0xffff0000u) + __uint_as_float(mq.y & 0xffff0000u);
                    s += (v[j].x + v[j].y) + (v[j].z + v[j].w); }
                const float mean = wave_sum(s) * (1.f / D); float s2 = 0.f;
#pragma unroll
                for (int j = 0; j < 8; ++j) { v[j] = v[j] - mean; s2 += (v[j].x * v[j].x + v[j].y * v[j].y) + (v[j].z * v[j].z + v[j].w * v[j].w); }
                const float rstd = 1.f / sqrtf(wave_sum(s2) * (1.f / D) + LN_EPS);
#pragma unroll
                for (int jh = 0; jh < 2; ++jh) {
                    f32x4 gg[4], bb[4];
#pragma unroll
                    for (int j4 = 0; j4 < 4; ++j4) { const int c = 4 * lane + 256 * (4 * jh + j4); gg[j4] = *(const f32x4*)(g1 + c); bb[j4] = *(const f32x4*)(b1 + c); }
#pragma unroll
                    for (int j4 = 0; j4 < 4; ++j4) {
                        const int j = 4 * jh + j4, c = 4 * lane + 256 * j;
                        v[j] = v[j] * rstd * gg[j4] + bb[j4];
                        *(LAS f32x4*)(L + tl * LN1_ROW + c * 4) = v[j];
                        v2u o; o.x = pk2(v[j].x, v[j].y); o.y = pk2(v[j].z, v[j].w);
                        *(v2u*)(x1b + (size_t)t * D + c) = o;
                        int p8 = 0; p8 = __builtin_amdgcn_cvt_pk_fp8_f32(v[j].x, v[j].y, p8, false); p8 = __builtin_amdgcn_cvt_pk_fp8_f32(v[j].z, v[j].w, p8, true);
                        *(int*)(x1f8 + (size_t)t * D + c) = p8;
                    }
                }
            }
            __syncthreads();
            f32x4 c0 = (f32x4){0.f, 0.f, 0.f, 0.f}, c1 = c0, c2 = c0;
            {
                typedef short bf16x8_ __attribute__((ext_vector_type(8)));
                const LAS unsigned char* xa = L + i * LN1_ROW + (256 * w + 8 * g) * 4;
                const bf16_t* wb = WrT + (size_t)(w * 8) * 3 * 2 * 512 + lane * 8;
                v4u wf[6], wn[6];
#define LN1_LDW(dst, ks_) do { _Pragma("unroll") for (int nt = 0; nt < 3; ++nt) { dst[2 * nt] = *(const v4u*)(wb + (size_t)((((ks_) * 3 + nt) * 2) * 512)); dst[2 * nt + 1] = *(const v4u*)(wb + (size_t)((((ks_) * 3 + nt) * 2 + 1) * 512)); } } while (0)
                LN1_LDW(wf, 0);
#pragma unroll
                for (int ks = 0; ks < 8; ++ks) {
                    if (ks + 1 < 8) LN1_LDW(wn, ks + 1);
                    const f32x4 x0 = *(const LAS f32x4*)(xa + 128 * ks), x1 = *(const LAS f32x4*)(xa + 128 * ks + 16);
                    v4u hi, lo;
                    hi.x = pk2(x0.x, x0.y); hi.y = pk2(x0.z, x0.w); hi.z = pk2(x1.x, x1.y); hi.w = pk2(x1.z, x1.w);
                    lo.x = pk2(x0.x - __uint_as_float(hi.x << 16), x0.y - __uint_as_float(hi.x & 0xffff0000u)); lo.y = pk2(x0.z - __uint_as_float(hi.y << 16), x0.w - __uint_as_float(hi.y & 0xffff0000u));
                    lo.z = pk2(x1.x - __uint_as_float(hi.z << 16), x1.y - __uint_as_float(hi.z & 0xffff0000u)); lo.w = pk2(x1.z - __uint_as_float(hi.w << 16), x1.w - __uint_as_float(hi.w & 0xffff0000u));
                    const bf16x8_ ah = __builtin_bit_cast(bf16x8_, hi), al = __builtin_bit_cast(bf16x8_, lo);
#define LN1_RT(cacc, nt) do { const bf16x8_ wh = __builtin_bit_cast(bf16x8_, wf[2 * (nt)]), wl = __builtin_bit_cast(bf16x8_, wf[2 * (nt) + 1]); \
                        cacc = __builtin_amdgcn_mfma_f32_16x16x32_bf16(ah, wh, cacc, 0, 0, 0); cacc = __builtin_amdgcn_mfma_f32_16x16x32_bf16(ah, wl, cacc, 0, 0, 0); cacc = __builtin_amdgcn_mfma_f32_16x16x32_bf16(al, wh, cacc, 0, 0, 0); } while (0)
                    LN1_RT(c0, 0); LN1_RT(c1, 1); LN1_RT(c2, 2);
#undef LN1_RT
#pragma unroll
                    for (int q6 = 0; q6 < 6; ++q6) wf[q6] = wn[q6];
                }
#undef LN1_LDW
            }
            { LAS f32x4* xp = (LAS f32x4*)(PT + (w * 64 + lane) * 48); xp[0] = c0; xp[1] = c1; xp[2] = c2; }
            __syncthreads();
            if (w == 0) {
                const float bias0 = rbias[i], bias1 = rbias[16 + i], bias2 = rbias[32 + i];
                c0 = (f32x4){0.f, 0.f, 0.f, 0.f}; c1 = c0; c2 = c0;
#pragma unroll
                for (int w2 = 0; w2 < 8; ++w2) { const LAS f32x4* xp = (const LAS f32x4*)(PT + (w2 * 64 + lane) * 48); c0 += xp[0]; c1 += xp[1]; c2 += xp[2]; }
                LAS float* lgs = (LAS float*)(PT + 24576);
#pragma unroll
                for (int r = 0; r < 4; ++r) { LAS float* lp = lgs + (4 * g + r) * 48 + i; lp[0] = c0[r] + bias0; lp[16] = c1[r] + bias1; lp[32] = c2[r] + bias2; }
                asm volatile("s_waitcnt lgkmcnt(0)" ::: "memory");
                if (lane < 16) {
                    const int t = 64 * tb + 16 * sb + lane;
                    const LAS float* lp = lgs + lane * 48;
                    float pg[4]; float mg = -1e30f; int gi = 0;
#pragma unroll
                    for (int gq = 0; gq < 4; ++gq) { pg[gq] = lp[gq]; if (pg[gq] > mg) { mg = pg[gq]; gi = gq; } }
                    float sg = 0.f;
#pragma unroll
                    for (int gq = 0; gq < 4; ++gq) sg += __expf(pg[gq] - mg);
                    const float ggate = 1.f / sg;
                    float el[8];
#pragma unroll
                    for (int e = 0; e < 8; ++e) el[e] = lp[4 + 8 * gi + e];
                    float m1 = -1e30f, m2 = -1e30f; int i1 = 0, i2 = 0;
#pragma unroll
                    for (int e = 0; e < 8; ++e) { if (el[e] > m1) { m2 = m1; i2 = i1; m1 = el[e]; i1 = e; } else if (el[e] > m2) { m2 = el[e]; i2 = e; } }
                    const float e2 = __expf(m2 - m1); const float wa = 1.f / (1.f + e2), wb2 = e2 / (1.f + e2);
                    const int ea = gi * EPG + i1, eb_ = gi * EPG + i2;
                    rt_e[2 * t] = ea; rt_e[2 * t + 1] = eb_;
                    rt_w[2 * t] = ggate * wa; rt_w[2 * t + 1] = ggate * wb2;
                    elist[16 * sb + lane] = ea | (eb_ << 8);
                }
            }
        }
        if (w == 0) {
            if (lane < 32) lcnt[lane] = 0;
            asm volatile("s_waitcnt lgkmcnt(0)" ::: "memory");
            const int ee = elist[lane], ea = ee & 255, eb_ = ee >> 8, t = 64 * tb + lane;
            const int la = (int)__hip_atomic_fetch_add(&lcnt[ea], 1, __ATOMIC_RELAXED, __HIP_MEMORY_SCOPE_WORKGROUP), lb = (int)__hip_atomic_fetch_add(&lcnt[eb_], 1, __ATOMIC_RELAXED, __HIP_MEMORY_SCOPE_WORKGROUP);
            asm volatile("s_waitcnt lgkmcnt(0)" ::: "memory");
            if (lane < 32) { const int c = lcnt[lane]; lcnt[32 + lane] = (c > 0) ? (int)atomicAdd(cnt + lane, (unsigned)c) : 0; }
            asm volatile("s_waitcnt vmcnt(0) lgkmcnt(0)" ::: "memory");
            const int ra = lcnt[32 + ea] + la, rb = lcnt[32 + eb_] + lb;
            rt_rank[2 * t] = ra; rt_rank[2 * t + 1] = rb;
            rowtok[ea * 16384 + ra] = t; rowtok[eb_ * 16384 + rb] = t;
        }
    }
    __syncthreads();
}

__device__ __forceinline__ void phase_final(const Frame& F, const Args& a) {
    float* outp = a.out; const unsigned char* Y = (const unsigned char*)(a.ws + WS_B); const bf16_t* x1b = (const bf16_t*)(a.ws + WS_X1F);
    const float* g2 = a.in[21]; const float* b2 = a.in[22];
    const int* rt_e = (const int*)(a.ws + WS_ROUTE + RT_E); const int* rt_rank = (const int*)(a.ws + WS_ROUTE + RT_RANK); const float* rt_w = (const float*)(a.ws + WS_ROUTE + RT_W);
    const LAS int* toff = (const LAS int*)(F.lds + MISC_OFF);
    const int lane = F.lane;
    typedef float f32x2_ __attribute__((ext_vector_type(2)));
    f32x4 gg[8], bb[8];
#pragma unroll
    for (int j = 0; j < 8; ++j) { const int c = 4 * lane + 256 * j; gg[j] = *(const f32x4*)(g2 + c); bb[j] = *(const f32x4*)(b2 + c); }
    int ne0 = 0, ne1 = 0, nr0 = 0, nr1 = 0; float nw0 = 0.f, nw1 = 0.f;
    if (F.gw < T) { const int t = F.gw; ne0 = rt_e[2 * t]; ne1 = rt_e[2 * t + 1]; nr0 = rt_rank[2 * t]; nr1 = rt_rank[2 * t + 1]; nw0 = rt_w[2 * t]; nw1 = rt_w[2 * t + 1]; }
    for (int t = F.gw; t < T; t += F.ngw) {
        const int p0 = toff[ne0] * 256 + nr0, p1 = toff[ne1] * 256 + nr1;
        const float w0 = nw0 * 0.0625f, w1 = nw1 * 0.0625f;
        { const int tn = t + F.ngw; if (tn < T) { ne0 = rt_e[2 * tn]; ne1 = rt_e[2 * tn + 1]; nr0 = rt_rank[2 * tn]; nr1 = rt_rank[2 * tn + 1]; nw0 = rt_w[2 * tn]; nw1 = rt_w[2 * tn + 1]; } }
        v2u xq[8]; int yq0[8], yq1[8];
#pragma unroll
        for (int j = 0; j < 8; ++j) { const int c = 4 * lane + 256 * j;
            xq[j] = __builtin_nontemporal_load((const v2u*)(x1b + (size_t)t * D + c)); yq0[j] = __builtin_nontemporal_load((const int*)(Y + (size_t)p0 * D + c)); yq1[j] = __builtin_nontemporal_load((const int*)(Y + (size_t)p1 * D + c)); }
        f32x4 v[8]; float s = 0.f; float* xr = outp + (size_t)t * D;
#pragma unroll
        for (int j = 0; j < 8; ++j) { const v2u xb2 = xq[j];
            f32x4 xv; xv.x = __uint_as_float(xb2.x << 16); xv.y = __uint_as_float(xb2.x & 0xffff0000u); xv.z = __uint_as_float(xb2.y << 16); xv.w = __uint_as_float(xb2.y & 0xffff0000u);
            const f32x2_ a0 = __builtin_amdgcn_cvt_pk_f32_fp8(yq0[j], false), a1 = __builtin_amdgcn_cvt_pk_f32_fp8(yq0[j], true);
            const f32x2_ c0 = __builtin_amdgcn_cvt_pk_f32_fp8(yq1[j], false), c1 = __builtin_amdgcn_cvt_pk_f32_fp8(yq1[j], true);
            f32x4 m;
            m.x = w0 * a0.x + w1 * c0.x; m.y = w0 * a0.y + w1 * c0.y; m.z = w0 * a1.x + w1 * c1.x; m.w = w0 * a1.y + w1 * c1.y;
            v[j] = xv * ALPHA + m; s += (v[j].x + v[j].y) + (v[j].z + v[j].w); }
        const float mean = wave_sum(s) * (1.f / D); float s2 = 0.f;
#pragma unroll
        for (int j = 0; j < 8; ++j) { v[j] = v[j] - mean; s2 += (v[j].x * v[j].x + v[j].y * v[j].y) + (v[j].z * v[j].z + v[j].w * v[j].w); }
        const float rstd = 1.f / sqrtf(wave_sum(s2) * (1.f / D) + LN_EPS);
#pragma unroll
        for (int j = 0; j < 8; ++j) { const int c = 4 * lane + 256 * j; __builtin_nontemporal_store(v[j] * rstd * gg[j] + bb[j], (f32x4*)(xr + c)); }
    }
}


namespace g8 {
typedef short bf16x8 __attribute__((ext_vector_type(8)));
typedef int v8i __attribute__((ext_vector_type(8)));
typedef int v4i __attribute__((ext_vector_type(4)));
constexpr int BM = 256, BK = 64, HALF = 128, HTB = HALF * BK * 2, STAGE_BYTES = 8 * HTB;
__device__ __forceinline__ int lds_byte(int r, int c) { const int st = (r >> 4) * 2 + (c >> 5), rr = r & 15, cc = c & 31, ob = rr * 64 + cc * 2; return st * 1024 + (ob ^ (((ob >> 9) & 1) << 5)); }
__device__ __forceinline__ void stage_rc(int b, int& R, int& C) { const int st = b / 1024, sb = b % 1024, swz = sb ^ (((sb >> 9) & 1) << 5); R = (st >> 1) * 16 + swz / 64; C = (st & 1) * 32 + (swz % 64) / 2; }
__device__ __forceinline__ int perm32(int rho) { const int n = rho >> 4, i = rho & 15; return 8 * (i >> 2) + 4 * n + (i & 3); }
__device__ __forceinline__ unsigned cvt_pk_bf16(float lo, float hi) { unsigned r; asm volatile("v_cvt_pk_bf16_f32 %0, %1, %2" : "=v"(r) : "v"(lo), "v"(hi)); return r; }
struct Unit { int pm, pn, e; };

template <class P, bool SP2 = true>
__device__ __forceinline__ void gemm_phase(LAS unsigned char* lds, const P& prob) {
    const int tid = threadIdx.x, wid = __builtin_amdgcn_readfirstlane(tid >> 6), lane = tid & 63, wr = wid >> 2, wc = wid & 3, fr = lane & 15, fq = lane >> 4;
    constexpr bool F8 = P::FP8;
    constexpr int K = P::K, KB = F8 ? K : 2 * K, nt = KB / 128;
    unsigned voffB[2]; int RA[2]; unsigned CA2[2];
#pragma unroll
    for (int i = 0; i < 2; ++i) { int R, C; stage_rc(tid * 16 + i * 8192, R, C); const int Rb = P::PERM ? ((R & ~31) + perm32(R & 31)) : R;
        RA[i] = R; CA2[i] = (unsigned)C * 2u; voffB[i] = (unsigned)(Rb * KB) + (unsigned)C * 2u; }
    constexpr size_t kstep = (size_t)(BK * 2);
    constexpr size_t hstep = (size_t)HALF * KB;
    const unsigned ldsw = (unsigned)wid * 1024u;
    const int aoff = lds_byte(wr * 64 + fr, F8 ? fq * 16 : fq * 8), boff = lds_byte(wc * 32 + fr, F8 ? fq * 16 : fq * 8);
    constexpr int aoff1 = F8 ? 16 : 1024, boff1 = F8 ? 16 : 1024;
    const char* const Abase = prob.a_base();
#define G8_SA(b, h) (((b) * 2 + (h)) * HTB)
#define G8_SB(b, h) ((4 + (b) * 2 + (h)) * HTB)
#define G8_STAGE_B(bufoff, gbase) do { _Pragma("unroll") for (int _i = 0; _i < 2; ++_i) \
        __builtin_amdgcn_global_load_lds((const unsigned*)((const char*)(gbase) + voffB[_i]), (LAS unsigned*)(lds + (bufoff) + ldsw + _i * 8192), 16, 0, 0); } while (0)
#define G8_STAGE_A(bufoff, kbyte, vo) do { _Pragma("unroll") for (int _i = 0; _i < 2; ++_i) \
        __builtin_amdgcn_global_load_lds((const unsigned*)(Abase + (size_t)(kbyte) + (vo)[_i]), (LAS unsigned*)(lds + (bufoff) + ldsw + _i * 8192), 16, 0, 0); } while (0)
#define G8_LDA(dst, b, h) do { _Pragma("unroll") for (int m = 0; m < 4; ++m) { if constexpr (F8) { const LAS unsigned char* q_ = lds + G8_SA(b, h) + aoff + m * 2048; \
            dst##8[m] = __builtin_shufflevector(*(const LAS v4i*)q_, *(const LAS v4i*)(q_ + aoff1), 0, 1, 2, 3, 4, 5, 6, 7); } \
        else { _Pragma("unroll") for (int k = 0; k < 2; ++k) dst[m][k] = *(const LAS bf16x8*)(lds + G8_SA(b, h) + aoff + m * 2048 + k * aoff1); } } } while (0)
#define G8_LDB(dst, b, h) do { _Pragma("unroll") for (int n = 0; n < 2; ++n) { if constexpr (F8) { const LAS unsigned char* q_ = lds + G8_SB(b, h) + boff + n * 2048; \
            dst##8[n] = __builtin_shufflevector(*(const LAS v4i*)q_, *(const LAS v4i*)(q_ + boff1), 0, 1, 2, 3, 4, 5, 6, 7); } \
        else { _Pragma("unroll") for (int k = 0; k < 2; ++k) dst[n][k] = *(const LAS bf16x8*)(lds + G8_SB(b, h) + boff + n * 2048 + k * boff1); } } } while (0)
#define G8_MMA(ai, bj, At, Bt) do { __builtin_amdgcn_s_setprio(1); _Pragma("unroll") for (int m = 0; m < 4; ++m) _Pragma("unroll") for (int n = 0; n < 2; ++n) { \
        if constexpr (F8) asm volatile("v_mfma_scale_f32_16x16x128_f8f6f4 %0, %1, %2, %0, %3, %4 op_sel_hi:[0,0,0]" : "+v"(acc[ai][bj][m][n]) : "v"(Bt##8[n]), "v"(At##8[m]), "v"(sclB), "v"(sclA)); \
        else { _Pragma("unroll") for (int k = 0; k < 2; ++k) acc[ai][bj][m][n] = __builtin_amdgcn_mfma_f32_16x16x32_bf16(Bt[n][k], At[m][k], acc[ai][bj][m][n], 0, 0, 0); } } \
        __builtin_amdgcn_s_setprio(0); } while (0)
#define G8_WAIT_V(n) asm volatile("s_waitcnt vmcnt(" #n ")" ::: "memory")
#define G8_WAIT_L(n) asm volatile("s_waitcnt lgkmcnt(" #n ")" ::: "memory")
#define G8_BAR __builtin_amdgcn_s_barrier()
#define G8_SCHED __builtin_amdgcn_sched_barrier(0)
    Unit cur, nxt; int ui = 0;
    if (!prob.next(0, cur)) return;
    f32x4 acc[2][2][4][2];
#pragma unroll
    for (int a = 0; a < 2; ++a)
#pragma unroll
        for (int b = 0; b < 2; ++b)
#pragma unroll
            for (int m = 0; m < 4; ++m)
#pragma unroll
                for (int n = 0; n < 2; ++n) acc[a][b][m][n] = (f32x4){0.f, 0.f, 0.f, 0.f};
    bf16x8 At[4][2], B0[2][2], B1[2][2];
    v8i At8[4], B08[2], B18[2];
    const int sclA = P::SCALE_A, sclB = P::SCALE_B;
    unsigned voC[2][2], voN[2][2];
#pragma unroll
    for (int h = 0; h < 2; ++h)
#pragma unroll
        for (int i = 0; i < 2; ++i) voC[h][i] = prob.a_off(cur, h * HALF + RA[i]) + CA2[i];
    const char* cB = prob.b_tile(cur);
    if constexpr (SP2) {
    G8_STAGE_B(G8_SB(0, 0), cB); G8_STAGE_B(G8_SB(0, 1), cB + hstep); G8_STAGE_A(G8_SA(0, 0), 0, voC[0]); G8_STAGE_A(G8_SA(0, 1), 0, voC[1]);
    if (wr == 1) G8_BAR;
    G8_WAIT_V(2); G8_BAR;
    G8_STAGE_B(G8_SB(1, 0), cB + kstep); G8_STAGE_A(G8_SA(1, 0), kstep, voC[0]); G8_STAGE_B(G8_SB(1, 1), cB + hstep + kstep);
    G8_WAIT_V(6); G8_BAR;
    } else {
    G8_STAGE_B(G8_SB(0, 0), cB); G8_STAGE_A(G8_SA(0, 0), 0, voC[0]); G8_STAGE_B(G8_SB(0, 1), cB + hstep); G8_STAGE_A(G8_SA(0, 1), 0, voC[1]);
    if (wr == 1) G8_BAR;
    G8_WAIT_V(4); G8_BAR;
    G8_STAGE_B(G8_SB(1, 0), cB + kstep); G8_STAGE_A(G8_SA(1, 0), kstep, voC[0]); G8_STAGE_B(G8_SB(1, 1), cB + hstep + kstep);
    G8_WAIT_V(6); G8_BAR;
    }
    for (;;) {
        const bool has_next = prob.next(ui + 1, nxt);
        const char* nB = cB;
        if (has_next) {
            nB = prob.b_tile(nxt);
#pragma unroll
            for (int h = 0; h < 2; ++h)
#pragma unroll
                for (int i = 0; i < 2; ++i) voN[h][i] = prob.a_off(nxt, h * HALF + RA[i]) + CA2[i];
        } else {
#pragma unroll
            for (int h = 0; h < 2; ++h)
#pragma unroll
                for (int i = 0; i < 2; ++i) voN[h][i] = voC[h][i];
        }
        for (int t = 0; t < nt; t += 2) {
            const bool last = (t == nt - 2);
            const size_t k1 = (size_t)(t + 1) * kstep;
            const size_t k2 = last ? 0 : (size_t)(t + 2) * kstep, k3 = k2 + kstep;
            const char* b2 = last ? nB : cB + (size_t)(t + 2) * kstep; const char* b3 = b2 + kstep;
            unsigned vo2[2][2];
#pragma unroll
            for (int h = 0; h < 2; ++h)
#pragma unroll
                for (int i = 0; i < 2; ++i) vo2[h][i] = last ? voN[h][i] : voC[h][i];
            if constexpr (SP2) {
            G8_LDB(B0, 0, 0); G8_LDB(B1, 0, 1); G8_SCHED; G8_LDA(At, 0, 0); G8_STAGE_A(G8_SA(1, 1), k1, voC[1]);
            G8_WAIT_V(8); G8_WAIT_L(0); G8_BAR; G8_MMA(0, 0, At, B0); G8_MMA(0, 1, At, B1); G8_BAR; G8_SCHED;
            G8_LDA(At, 0, 1); G8_STAGE_B(G8_SB(0, 0), b2); G8_STAGE_B(G8_SB(0, 1), b2 + hstep); G8_STAGE_A(G8_SA(0, 0), k2, vo2[0]);
            G8_WAIT_V(8); G8_WAIT_L(0); G8_BAR; G8_MMA(1, 0, At, B0); G8_MMA(1, 1, At, B1); G8_BAR; G8_SCHED;
            G8_LDB(B0, 1, 0); G8_LDB(B1, 1, 1); G8_SCHED; G8_LDA(At, 1, 0); G8_STAGE_A(G8_SA(0, 1), k2, vo2[1]);
            G8_WAIT_V(8); G8_WAIT_L(0); G8_BAR; G8_MMA(0, 0, At, B0); G8_MMA(0, 1, At, B1); G8_BAR; G8_SCHED;
            G8_LDA(At, 1, 1); G8_STAGE_B(G8_SB(1, 0), b3); G8_STAGE_B(G8_SB(1, 1), b3 + hstep); G8_STAGE_A(G8_SA(1, 0), k3, vo2[0]);
            G8_WAIT_V(8); G8_WAIT_L(0); G8_BAR; G8_MMA(1, 0, At, B0); G8_MMA(1, 1, At, B1); G8_BAR; G8_SCHED;
            } else {
            G8_LDB(B0, 0, 0); G8_SCHED; G8_LDA(At, 0, 0); G8_STAGE_A(G8_SA(1, 1), k1, voC[1]);
            G8_WAIT_L(8); G8_BAR; G8_WAIT_L(0); G8_MMA(0, 0, At, B0); G8_BAR; G8_SCHED;
            G8_LDB(B1, 0, 1); G8_STAGE_B(G8_SB(0, 0), b2);
            G8_BAR; G8_WAIT_L(0); G8_MMA(0, 1, At, B1); G8_BAR;
            G8_LDA(At, 0, 1); G8_STAGE_A(G8_SA(0, 0), k2, vo2[0]);
            G8_BAR; G8_WAIT_L(0); G8_MMA(1, 0, At, B0); G8_BAR; G8_SCHED;
            G8_STAGE_B(G8_SB(0, 1), b2 + hstep);
            G8_WAIT_V(6); G8_BAR; G8_MMA(1, 1, At, B1); G8_BAR;
            G8_LDB(B0, 1, 0); G8_SCHED; G8_LDA(At, 1, 0); G8_STAGE_A(G8_SA(0, 1), k2, vo2[1]);
            G8_WAIT_L(8); G8_BAR; G8_WAIT_L(0); G8_MMA(0, 0, At, B0); G8_BAR; G8_SCHED;
            G8_LDB(B1, 1, 1); G8_STAGE_B(G8_SB(1, 0), b3);
            G8_BAR; G8_WAIT_L(0); G8_MMA(0, 1, At, B1); G8_BAR;
            G8_LDA(At, 1, 1); G8_STAGE_A(G8_SA(1, 0), k3, vo2[0]);
            G8_BAR; G8_WAIT_L(0); G8_MMA(1, 0, At, B0); G8_BAR; G8_SCHED;
            G8_STAGE_B(G8_SB(1, 1), b3 + hstep);
            G8_WAIT_V(6); G8_BAR; G8_MMA(1, 1, At, B1); G8_BAR;
            }
        }
        if (wr == 0) G8_BAR;
        prob.epi(acc, cur, wr, wc, fr, fq);
        prob.done(cur);
        if (!has_next) break;
#pragma unroll
        for (int a = 0; a < 2; ++a)
#pragma unroll
            for (int b = 0; b < 2; ++b)
#pragma unroll
                for (int m = 0; m < 4; ++m)
#pragma unroll
                    for (int n = 0; n < 2; ++n) acc[a][b][m][n] = (f32x4){0.f, 0.f, 0.f, 0.f};
        cur = nxt; cB = nB; ++ui;
#pragma unroll
        for (int h = 0; h < 2; ++h)
#pragma unroll
            for (int i = 0; i < 2; ++i) voC[h][i] = voN[h][i];
        if (wr == 1) G8_BAR;
    }
    G8_WAIT_V(0);
    G8_BAR;
#undef G8_SA
#undef G8_SB
#undef G8_STAGE_A
#undef G8_STAGE_B
#undef G8_LDA
#undef G8_LDB
#undef G8_MMA
#undef G8_WAIT_V
#undef G8_WAIT_L
#undef G8_BAR
#undef G8_SCHED
}

struct DenseOrder {
    int nM, nN, nwg, G, c, i0, i1;
    __device__ __forceinline__ void init(int M, int N, int G_, int c_) { nM = M / BM; nN = N / BM; nwg = nM * nN; G = G_; c = c_; i0 = 0; i1 = 1 << 30; }
    __device__ __forceinline__ bool next(int i, Unit& u) const {
        if (i + i0 >= i1) return false;
        const long L = (long)(i + i0) * G + c; if (L >= nwg) return false;
        int wgid = (int)L; { const int q = nwg / 8, r = nwg % 8, xcd = wgid % 8, off = wgid / 8; wgid = (xcd < r ? xcd * (q + 1) : r * (q + 1) + (xcd - r) * q) + off; }
        const int nig = 8 * nN, gid = wgid / nig, fm = gid * 8, gsz = (nM - fm) < 8 ? (nM - fm) : 8;
        u.pm = fm + ((wgid % nig) % gsz); u.pn = (wgid % nig) / gsz; u.e = 0; return true;
    }
};

struct ProbProj {
    static constexpr int K = D; static constexpr bool PERM = true, FP8 = false; static constexpr int SCALE_A = 0, SCALE_B = 0;
    const char* A; const char* Bt; bf16_t* C; DenseOrder ord;
    __device__ __forceinline__ bool next(int i, Unit& u) const { return ord.next(i, u); }
    __device__ __forceinline__ void done(const Unit&) const {}
    __device__ __forceinline__ const char* a_base() const { return A; }
    __device__ __forceinline__ unsigned a_off(const Unit& u, int r) const { return (unsigned)(u.pm * BM + r) * (unsigned)(K * 2); }
    __device__ __forceinline__ const char* b_tile(const Unit& u) const { return Bt + (size_t)u.pn * BM * K * 2; }
    __device__ __forceinline__ void epi(const f32x4 (&acc)[2][2][4][2], const Unit& u, int wr, int wc, int fr, int fq) const {
        const int row0 = u.pm * BM + wr * 64 + fr, col0 = u.pn * BM + wc * 32 + 8 * fq;
#pragma unroll
        for (int ai = 0; ai < 2; ++ai)
#pragma unroll
            for (int m = 0; m < 4; ++m) { bf16_t* rowp = C + (size_t)(row0 + ai * HALF + m * 16) * DP + col0;
#pragma unroll
                for (int bj = 0; bj < 2; ++bj) { const f32x4 v0 = acc[ai][bj][m][0], v1 = acc[ai][bj][m][1];
                    v4u w; w.x = cvt_pk_bf16(v0[0], v0[1]); w.y = cvt_pk_bf16(v0[2], v0[3]); w.z = cvt_pk_bf16(v1[0], v1[1]); w.w = cvt_pk_bf16(v1[2], v1[3]);
                    if (u.pn >= 12) __builtin_nontemporal_store(w, (v4u*)(rowp + bj * HALF)); else *(v4u*)(rowp + bj * HALF) = w; } }
    }
};
struct ProbOut {
    static constexpr int K = D; static constexpr bool PERM = true, FP8 = false; static constexpr int SCALE_A = 0, SCALE_B = 0;
    const char* A; const char* Bt; bf16_t* C; DenseOrder ord;
    __device__ __forceinline__ bool next(int i, Unit& u) const { return ord.next(i, u); }
    __device__ __forceinline__ void done(const Unit&) const {}
    __device__ __forceinline__ const char* a_base() const { return A; }
    __device__ __forceinline__ unsigned a_off(const Unit& u, int r) const { return (unsigned)(u.pm * BM + r) * (unsigned)(K * 2); }
    __device__ __forceinline__ const char* b_tile(const Unit& u) const { return Bt + (size_t)u.pn * BM * K * 2; }
    __device__ __forceinline__ void epi(const f32x4 (&acc)[2][2][4][2], const Unit& u, int wr, int wc, int fr, int fq) const {
        const int row0 = u.pm * BM + wr * 64 + fr, col0 = u.pn * BM + wc * 32 + 8 * fq;
#pragma unroll
        for (int ai = 0; ai < 2; ++ai)
#pragma unroll
            for (int m = 0; m < 4; ++m) { bf16_t* rowp = C + (size_t)(row0 + ai * HALF + m * 16) * D + col0;
#pragma unroll
                for (int bj = 0; bj < 2; ++bj) { const f32x4 v0 = acc[ai][bj][m][0], v1 = acc[ai][bj][m][1];
                    v4u w; w.x = cvt_pk_bf16(v0[0], v0[1]); w.y = cvt_pk_bf16(v0[2], v0[3]); w.z = cvt_pk_bf16(v1[0], v1[1]); w.w = cvt_pk_bf16(v1[2], v1[3]);
                    *(v4u*)(rowp + bj * HALF) = w; } }
    }
};
struct MoeQueue {
    const LAS int* toff;
    LAS int* slots;
    unsigned* qhead; unsigned* ready; unsigned* tmo;
    template <bool DOWN>
    __device__ __forceinline__ bool claim(int i, Unit& u) const {
        const int NT = toff[NE], U = 4 * NT, DN = 8 * NT;
        if (threadIdx.x == 0) {
            int d; bool polled = false;
            if (DOWN && i == 0) d = slots[2];
            else if (DOWN && slots[3] >= 0) { d = slots[3]; slots[3] = -1; polled = (((d - U) & 7) != 0); }
            else if (!DOWN && i == 0) d = (int)blockIdx.x;
            else { d = (int)gridDim.x + (int)__hip_atomic_fetch_add(qhead, DOWN ? 2u : 1u, __ATOMIC_RELAXED, __HIP_MEMORY_SCOPE_AGENT); if (DOWN) slots[3] = d + 1; }
            if (!DOWN && d >= U) slots[2] = d;
            if (DOWN && d < U + DN && !polled) {
                const int rt = (d - U) >> 3; unsigned sp = 0;
                while (__hip_atomic_load(ready + 64 * rt, __ATOMIC_RELAXED, __HIP_MEMORY_SCOPE_AGENT) < 32u) {
                    __builtin_amdgcn_s_sleep(2);
                    if ((++sp & 255u) == 0u) { if (__hip_atomic_load(tmo, __ATOMIC_RELAXED, __HIP_MEMORY_SCOPE_AGENT)) break; if (sp > (1u << 20)) { atomicAdd(tmo, 1u); break; } } }
                __builtin_amdgcn_fence(__ATOMIC_ACQUIRE, "agent");
                asm volatile("s_waitcnt vmcnt(0)" ::: "memory");
            }
            slots[i & 1] = d;
        }
        asm volatile("s_waitcnt lgkmcnt(0)" ::: "memory"); __builtin_amdgcn_s_barrier(); asm volatile("" ::: "memory");
        const int d = __builtin_amdgcn_readfirstlane(slots[i & 1]);
        if (!DOWN) { if (d >= U) return false; u.pm = d >> 2; u.pn = d & 3; }
        else { if (d >= U + DN) return false; u.pm = (d - U) >> 3; u.pn = (d - U) & 7; }
        const int ln_ = (int)threadIdx.x & 63, myoff = (ln_ < NE) ? toff[ln_] : 0x7fffffff;
        const unsigned long long mk = __builtin_amdgcn_ballot_w64(u.pm >= myoff);
        u.e = __builtin_amdgcn_readfirstlane(63 - (int)__builtin_clzll(mk)); return true;
    }
};
__device__ __forceinline__ void store8_sc1(void* p, v2u v) { asm volatile("global_store_dwordx2 %0, %1, off sc1\n\ts_nop 1" :: "v"(p), "v"(v) : "memory"); }
__device__ __forceinline__ void store16_sc1(void* p, v4u v) { asm volatile("global_store_dwordx4 %0, %1, off sc1\n\ts_nop 1" :: "v"(p), "v"(v) : "memory"); }
struct ProbUp {
    static constexpr int K = D; static constexpr bool PERM = true, FP8 = true;
    static constexpr int SCALE_A = 0x7f7f7f7f, SCALE_B = 0x79797979;
    const char* A; const char* Bt; unsigned char* H; const int* rowtok; MoeQueue q;
    __device__ __forceinline__ bool next(int i, Unit& u) const { return q.claim<false>(i, u); }
    __device__ __forceinline__ void done(const Unit& u) const {
        asm volatile("s_waitcnt vmcnt(0)" ::: "memory");
        if ((threadIdx.x & 63) == 0) __hip_atomic_fetch_add(q.ready + 64 * u.pm, 1u, __ATOMIC_RELAXED, __HIP_MEMORY_SCOPE_AGENT);
    }
    __device__ __forceinline__ const char* a_base() const { return A; }
    __device__ __forceinline__ unsigned a_off(const Unit& u, int r) const { const int rank = (u.pm - q.toff[u.e]) * BM + r; const int tok = (rank < q.toff[64 + u.e]) ? rowtok[u.e * 16384 + rank] : 0; return (unsigned)tok * (unsigned)K; }
    __device__ __forceinline__ const char* b_tile(const Unit& u) const { return Bt + ((size_t)u.e * 1024 + (size_t)u.pn * BM) * K; }
    __device__ __forceinline__ void epi(const f32x4 (&acc)[2][2][4][2], const Unit& u, int wr, int wc, int fr, int fq) const {
        const int row0 = u.pm * BM + wr * 64 + fr, col0 = u.pn * HALF + wc * 32 + 8 * fq;
#pragma unroll
        for (int ai = 0; ai < 2; ++ai)
#pragma unroll
            for (int m = 0; m < 4; ++m) { unsigned char* rowp = H + (size_t)(row0 + ai * HALF + m * 16) * DE + col0;
                float hv[8];
#pragma unroll
                for (int n = 0; n < 2; ++n)
#pragma unroll
                    for (int j = 0; j < 4; ++j) { const float g = acc[ai][0][m][n][j], v = acc[ai][1][m][n][j]; hv[n * 4 + j] = g * __builtin_amdgcn_rcpf(1.f + __expf(-g)) * v; }
                int p0 = 0, p1 = 0;
                p0 = __builtin_amdgcn_cvt_pk_fp8_f32(hv[0], hv[1], p0, false); p0 = __builtin_amdgcn_cvt_pk_fp8_f32(hv[2], hv[3], p0, true);
                p1 = __builtin_amdgcn_cvt_pk_fp8_f32(hv[4], hv[5], p1, false); p1 = __builtin_amdgcn_cvt_pk_fp8_f32(hv[6], hv[7], p1, true);
                store8_sc1(rowp, (v2u){(unsigned)p0, (unsigned)p1}); }
    }
};
struct ProbDown {
    static constexpr int K = DE; static constexpr bool PERM = true, FP8 = true;
    static constexpr int SCALE_A = 0x7f7f7f7f, SCALE_B = 0x7d7d7d7d;
    const char* A; const char* Bt; unsigned char* Y; MoeQueue q;
    __device__ __forceinline__ bool next(int i, Unit& u) const { return q.claim<true>(i, u); }
    __device__ __forceinline__ void done(const Unit&) const {}
    __device__ __forceinline__ const char* a_base() const { return A; }
    __device__ __forceinline__ unsigned a_off(const Unit& u, int r) const { return (unsigned)(u.pm * BM + r) * (unsigned)K; }
    __device__ __forceinline__ const char* b_tile(const Unit& u) const { return Bt + ((size_t)u.e * D + (size_t)u.pn * BM) * K; }
    __device__ __forceinline__ void epi(const f32x4 (&acc)[2][2][4][2], const Unit& u, int wr, int wc, int fr, int fq) const {
        const int row0 = u.pm * BM + wr * 64 + fr, col0 = u.pn * BM + wc * 32 + 8 * fq;
#pragma unroll
        for (int ai = 0; ai < 2; ++ai)
#pragma unroll
            for (int m = 0; m < 4; ++m) { unsigned char* rowp = Y + (size_t)(row0 + ai * HALF + m * 16) * D + col0;
#pragma unroll
                for (int bj = 0; bj < 2; ++bj) { const f32x4 v0 = acc[ai][bj][m][0], v1 = acc[ai][bj][m][1];
                    int p0 = 0, p1 = 0;
                    p0 = __builtin_amdgcn_cvt_pk_fp8_f32(v0[0], v0[1], p0, false); p0 = __builtin_amdgcn_cvt_pk_fp8_f32(v0[2], v0[3], p0, true);
                    p1 = __builtin_amdgcn_cvt_pk_fp8_f32(v1[0], v1[1], p1, false); p1 = __builtin_amdgcn_cvt_pk_fp8_f32(v1[2], v1[3], p1, true);
                    v2u w; w.x = (unsigned)p0; w.y = (unsigned)p1;
                    *(v2u*)(rowp + bj * HALF) = w; } }
    }
};
}


namespace att {
typedef short bf16x8 __attribute__((ext_vector_type(8)));
typedef short s16x4 __attribute__((ext_vector_type(4)));
constexpr int NUNITS = 3 * NBATCH * NH * 32;
constexpr float LOG2E = 1.4426950408889634f, LN2 = 0.6931471805599453f;
__device__ __forceinline__ s16x4 vtr(const LAS unsigned char* p) { return __builtin_bit_cast(s16x4, __builtin_amdgcn_ds_read_tr16_b64_v4i16((LAS s16x4*)p)); }
__device__ __forceinline__ unsigned cvt_pk_bf16(float lo, float hi) { unsigned r; asm volatile("v_cvt_pk_bf16_f32 %0, %1, %2" : "=v"(r) : "v"(lo), "v"(hi)); return r; }

struct UnitA { int p, b, h, r, n, dil; };
__device__ __forceinline__ UnitA decode(int u) {
    UnitA x; x.p = u >> 11; const int rem = u & 2047; x.b = rem >> 9; x.h = (rem >> 5) & 15; const int j = rem & 31;
    x.dil = 1 << (2 * x.p); const int nblk = 32 >> (2 * x.p); x.r = j / nblk; x.n = j % nblk; return x;
}

__device__ __forceinline__ void attn_phase(const Frame& F, const Args& a) {
    const bf16_t* proj = (const bf16_t*)(a.ws + WS_B);
    const int tid = F.tid, lane = F.lane, w = F.wave, i = lane & 15, g = lane >> 4;
    const bool xo = (gridDim.x == 256);
    const int per = xo ? 24 : (NUNITS + (int)gridDim.x - 1) / (int)gridDim.x;
    const int u0 = xo ? 0 : (int)blockIdx.x * per, u1 = xo ? 24 : ((u0 + per < NUNITS) ? (u0 + per) : NUNITS);
    if (u0 >= u1) return;
    const int xcd_ = (int)blockIdx.x & 7, rank_ = (int)blockIdx.x >> 3;
#define ATT_UNIT(k) (xo ? ({ const int s_ = (k) / 3, ul_ = rank_ * 3 + ((k) - 3 * s_), pair_ = xcd_ * 8 + s_; ((ul_ >> 5) << 11) + ((pair_ >> 4) << 9) + ((pair_ & 15) << 5) + (ul_ & 31); }) : (k))
    v4u kst[4], vst[4], qst[2];
    const unsigned kvo0 = (unsigned)(tid >> 3) * (unsigned)(DP * 2), kvo1 = (unsigned)(tid & 7) * 16u;
    const unsigned qvo0 = (unsigned)(16 * w + i) * (unsigned)(DP * 2), qvo1 = (unsigned)g * 16u;
#define ATT_LOAD(U) do { const UnitA x_ = decode(U); const int sh_ = 2 * x_.p; \
        const char* kb_ = (const char*)proj + ((long)x_.b * SEQ + (long)(128 * (x_.n - 1)) * x_.dil + x_.r) * (long)(DP * 2) + (long)((DA + x_.h * HD) * 2); \
        const unsigned vo_ = (kvo0 << sh_) + kvo1; \
        _Pragma("unroll") for (int jj = 0; jj < 4; ++jj) { \
            if (x_.n > 0 || jj >= 2) { const char* kp = kb_ + ((size_t)(64 * jj) * (size_t)(DP * 2) << sh_); kst[jj] = *(const v4u*)(kp + vo_); vst[jj] = *(const v4u*)(kp + vo_ + DA * 2); } \
            else { kst[jj] = (v4u){0u, 0u, 0u, 0u}; vst[jj] = (v4u){0u, 0u, 0u, 0u}; } } \
        { const char* qb_ = (const char*)proj + ((long)x_.b * SEQ + (long)(128 * x_.n) * x_.dil + x_.r) * (long)(DP * 2) + (long)(x_.h * HD * 2); const unsigned qo_ = (qvo0 << sh_) + qvo1; \
          qst[0] = *(const v4u*)(qb_ + qo_); qst[1] = *(const v4u*)(qb_ + qo_ + 64); } } while (0)
    ATT_LOAD(ATT_UNIT(u0));
    const int ts = w & ~1;
    const int kaddr0 = (16 * ts + i) * 128 + (((g) ^ (i & 7)) << 4), kaddr1 = (16 * ts + i) * 128 + (((g + 4) ^ (i & 7)) << 4);
    int vaddr[4];
    { const int q = i >> 2, p_ = i & 3, key = 16 * ts + 4 * g + q, k7 = key & 7;
#pragma unroll
      for (int dt = 0; dt < 4; ++dt) vaddr[dt] = key * 128 + (((2 * dt + (p_ >> 1)) ^ k7) << 4) + (p_ & 1) * 8; }
    bf16x8 qf[2];
#define ATT_STAGE(U_) do { LAS unsigned char* Kw_ = F.lds + (((U_) - u0) & 1) * 65536; \
        _Pragma("unroll") for (int jj = 0; jj < 4; ++jj) { const int cidx = tid + 512 * jj, key = cidx >> 3, ch = cidx & 7; const int la = key * 128 + ((ch ^ (key & 7)) << 4); \
            *(LAS v4u*)(Kw_ + la) = kst[jj]; *(LAS v4u*)(Kw_ + 32768 + la) = vst[jj]; } \
        qf[0] = __builtin_bit_cast(bf16x8, qst[0]); qf[1] = __builtin_bit_cast(bf16x8, qst[1]); } while (0)
    __syncthreads();
    ATT_STAGE(u0);
    __syncthreads();
    if (u0 + 1 < u1) ATT_LOAD(ATT_UNIT(u0 + 1));
    for (int u = u0; u < u1; ++u) {
        const UnitA x = decode(ATT_UNIT(u));
        const LAS unsigned char* Kl = F.lds + ((u - u0) & 1) * 65536; const LAS unsigned char* Vl = Kl + 32768;
        f32x4 S[10];
        {
            bf16x8 ka[2][2], kb[2][2];
#define ATT_LDK(dst, Tt) do { dst[0][0] = *(const LAS bf16x8*)(Kl + kaddr0 + (Tt) * 2048); dst[0][1] = *(const LAS bf16x8*)(Kl + kaddr1 + (Tt) * 2048); \
                              dst[1][0] = *(const LAS bf16x8*)(Kl + kaddr0 + ((Tt) + 1) * 2048); dst[1][1] = *(const LAS bf16x8*)(Kl + kaddr1 + ((Tt) + 1) * 2048); } while (0)
#define ATT_QK(src, Tt) do { f32x4 z0 = (f32x4){0.f, 0.f, 0.f, 0.f}, z1 = z0; \
            z0 = __builtin_amdgcn_mfma_f32_16x16x32_bf16(src[0][0], qf[0], z0, 0, 0, 0); z1 = __builtin_amdgcn_mfma_f32_16x16x32_bf16(src[1][0], qf[0], z1, 0, 0, 0); \
            S[Tt] = __builtin_amdgcn_mfma_f32_16x16x32_bf16(src[0][1], qf[1], z0, 0, 0, 0); S[(Tt) + 1] = __builtin_amdgcn_mfma_f32_16x16x32_bf16(src[1][1], qf[1], z1, 0, 0, 0); } while (0)
            ATT_LDK(ka, 0); ATT_LDK(kb, 2); __builtin_amdgcn_sched_barrier(0);
            ATT_QK(ka, 0); __builtin_amdgcn_sched_barrier(0); ATT_LDK(ka, 4); __builtin_amdgcn_sched_barrier(0);
            ATT_QK(kb, 2); __builtin_amdgcn_sched_barrier(0); ATT_LDK(kb, 6); __builtin_amdgcn_sched_barrier(0);
            ATT_QK(ka, 4); __builtin_amdgcn_sched_barrier(0); ATT_LDK(ka, 8); __builtin_amdgcn_sched_barrier(0);
            ATT_QK(kb, 6); __builtin_amdgcn_sched_barrier(0);
            ATT_QK(ka, 8); __builtin_amdgcn_sched_barrier(0);
#undef ATT_LDK
#undef ATT_QK
        }
        const float slope = exp2f(-0.5f * (float)(x.h + 1));
        const float c1 = 0.125f * LOG2E, c2 = slope * (float)x.dil * LOG2E;
        int dbase = 128 + 16 * w + i - 16 * ts - 4 * g;
        asm volatile("" : "+v"(dbase));
        const float nb = -c2 * (float)dbase;
        float m4[4] = {-INFINITY, -INFINITY, -INFINITY, -INFINITY};
#define ATT_SC_M(Tt, j) do { const int dist = dbase - (16 * (Tt) + (j)); const float tv0 = fmaf(S[Tt][j], c1, fmaf(c2, (float)(16 * (Tt) + (j)), nb)); \
            const float tv = ((unsigned)dist <= (unsigned)dmax) ? tv0 : -INFINITY; S[Tt][j] = tv; m4[j] = fmaxf(m4[j], tv); } while (0)
#define ATT_SC_U(Tt, j) do { const float tv = fmaf(S[Tt][j], c1, fmaf(c2, (float)(16 * (Tt) + (j)), nb)); S[Tt][j] = tv; m4[j] = fmaxf(m4[j], tv); } while (0)
        if (x.n > 0) {
            const int dmax = 128;
#pragma unroll
            for (int Tt = 0; Tt < 10; ++Tt)
#pragma unroll
                for (int j = 0; j < 4; ++j) { if (Tt < 2 || Tt > 7) ATT_SC_M(Tt, j); else ATT_SC_U(Tt, j); }
        } else {
            const int dmax = 16 * w + i;
#pragma unroll
            for (int Tt = 0; Tt < 10; ++Tt)
#pragma unroll
                for (int j = 0; j < 4; ++j) ATT_SC_M(Tt, j);
        }
#undef ATT_SC_M
#undef ATT_SC_U
        float m = fmaxf(fmaxf(m4[0], m4[1]), fmaxf(m4[2], m4[3]));
        m = fmaxf(m, __shfl_xor(m, 16)); m = fmaxf(m, __shfl_xor(m, 32));
        float l4[4] = {0.f, 0.f, 0.f, 0.f};
#pragma unroll
        for (int Tt = 0; Tt < 10; ++Tt)
#pragma unroll
            for (int j = 0; j < 4; ++j) { const float pv = __builtin_amdgcn_exp2f(S[Tt][j] - m); S[Tt][j] = pv; l4[j] += pv; }
        float l = (l4[0] + l4[1]) + (l4[2] + l4[3]);
        l += __shfl_xor(l, 16); l += __shfl_xor(l, 32);
        f32x4 O[4];
#pragma unroll
        for (int dt = 0; dt < 4; ++dt) O[dt] = (f32x4){0.f, 0.f, 0.f, 0.f};
        {
            s16x4 va[4][2], vb[4][2];
#define ATT_LDV(dst, c) do { _Pragma("unroll") for (int dt = 0; dt < 4; ++dt) { dst[dt][0] = vtr(Vl + vaddr[dt] + (c) * 4096); dst[dt][1] = vtr(Vl + vaddr[dt] + (c) * 4096 + 2048); } } while (0)
#define ATT_PV(src, c) do { v4u pw; pw.x = cvt_pk_bf16(S[2 * (c)][0], S[2 * (c)][1]); pw.y = cvt_pk_bf16(S[2 * (c)][2], S[2 * (c)][3]); \
            pw.z = cvt_pk_bf16(S[2 * (c) + 1][0], S[2 * (c) + 1][1]); pw.w = cvt_pk_bf16(S[2 * (c) + 1][2], S[2 * (c) + 1][3]); const bf16x8 pf = __builtin_bit_cast(bf16x8, pw); \
            _Pragma("unroll") for (int dt = 0; dt < 4; ++dt) { const v2u lo_ = __builtin_bit_cast(v2u, src[dt][0]), hi_ = __builtin_bit_cast(v2u, src[dt][1]); const bf16x8 vf = __builtin_bit_cast(bf16x8, ((v4u){lo_.x, lo_.y, hi_.x, hi_.y})); \
                O[dt] = __builtin_amdgcn_mfma_f32_16x16x32_bf16(vf, pf, O[dt], 0, 0, 0); } } while (0)
            ATT_LDV(va, 0); ATT_LDV(vb, 1); __builtin_amdgcn_sched_barrier(0);
            ATT_PV(va, 0); __builtin_amdgcn_sched_barrier(0); ATT_LDV(va, 2); __builtin_amdgcn_sched_barrier(0);
            ATT_PV(vb, 1); __builtin_amdgcn_sched_barrier(0); ATT_LDV(vb, 3); __builtin_amdgcn_sched_barrier(0);
            ATT_PV(va, 2); __builtin_amdgcn_sched_barrier(0); ATT_LDV(va, 4); __builtin_amdgcn_sched_barrier(0);
            ATT_PV(vb, 3); __builtin_amdgcn_sched_barrier(0);
            ATT_PV(va, 4); __builtin_amdgcn_sched_barrier(0);
#undef ATT_LDV
#undef ATT_PV
        }
        const float inv = __builtin_amdgcn_rcpf(l);
        const size_t tq = (size_t)x.b * SEQ + (size_t)(128 * x.n + 16 * w + i) * x.dil + x.r;
        bf16_t* op = (bf16_t*)((unsigned char*)a.out + DO_O + (size_t)x.p * DO_OSTRIDE) + tq * DA + x.h * HD + 4 * g;
#pragma unroll
        for (int dt = 0; dt < 4; ++dt) { v2u o; o.x = cvt_pk_bf16(O[dt][0] * inv, O[dt][1] * inv); o.y = cvt_pk_bf16(O[dt][2] * inv, O[dt][3] * inv); __builtin_nontemporal_store(o, (v2u*)(op + 16 * dt)); }
        if (g == 0) ((float*)(a.ws + WS_LSE))[((size_t)x.p * T + tq) * NH + x.h] = (m + __builtin_amdgcn_logf(l)) * LN2;
        if (u + 1 < u1) ATT_STAGE(u + 1);
        __syncthreads();
        if (u + 2 < u1) ATT_LOAD(ATT_UNIT(u + 2));
    }
#undef ATT_STAGE
#undef ATT_LOAD
#undef ATT_UNIT
}
}


namespace lru {
typedef short bf16x8 __attribute__((ext_vector_type(8)));
constexpr int NUNITS = NBATCH * 16 * 4;
constexpr int CHK = 512, NCHK = SEQ / CHK;
constexpr int OFF_XR = 0, XR_BYTES = (CHK + 4) * 128, OFF_XG = 66560, XG_BYTES = CHK * 32, OFF_WT = OFF_XG + XG_BYTES, OFF_CW = OFF_WT + 2048;
static_assert(XR_BYTES <= OFF_XG && OFF_CW + 16384 <= 131072, "LRU LDS map");
__device__ __forceinline__ unsigned cvt_pk_bf16(float lo, float hi) { unsigned r; asm volatile("v_cvt_pk_bf16_f32 %0, %1, %2" : "=v"(r) : "v"(lo), "v"(hi)); return r; }
__device__ __forceinline__ float sigm(float x) { return __builtin_amdgcn_rcpf(1.f + __expf(-x)); }

__device__ __forceinline__ void lru_phase(const Frame& F, const Args& a) {
    const bf16_t* proj = (const bf16_t*)(a.ws + WS_B);
    const int tid = F.tid, lane = F.lane, w = F.wave, i = lane & 15, g = lane >> 4;
    LAS unsigned char* L = F.lds;
    LAS unsigned char* XR = L + OFF_XR;
    LAS unsigned char* XG = L + OFF_XG;
    for (int uid = blockIdx.x; uid < NUNITS; uid += gridDim.x) {
        const int pair_ = (gridDim.x == 256) ? ((uid & 7) * 8 + (uid >> 5)) : (uid >> 2), q4 = (gridDim.x == 256) ? ((uid >> 3) & 3) : (uid & 3);
        const int b = pair_ >> 4, blk = pair_ & 15;
        const int cblk = blk * 64, ce = cblk + q4 * 16 + i;
        __syncthreads();
        float gbias[2];
        {
            const float* WgA = a.in[4] + (size_t)blk * 64 * 64 + q4 * 16 + i; const float* WgX = a.in[6] + (size_t)blk * 64 * 64 + q4 * 16 + i;
            float wvA[2][8], wvX[2][8]; f32x4 cwq[4][2][2];
#pragma unroll
            for (int ks = 0; ks < 2; ++ks)
#pragma unroll
                for (int j = 0; j < 8; ++j) { wvA[ks][j] = WgA[(8 * g + j + 32 * ks) * 64]; wvX[ks][j] = WgX[(8 * g + j + 32 * ks) * 64]; }
#pragma unroll
            for (int jj = 0; jj < 4; ++jj)
#pragma unroll
                for (int ks = 0; ks < 2; ++ks) { const float* cp = a.in[2] + jj * DL + cblk + 8 * g + 32 * ks; cwq[jj][ks][0] = *(const f32x4*)cp; cwq[jj][ks][1] = *(const f32x4*)(cp + 4); }
#pragma unroll
            for (int ks = 0; ks < 2; ++ks)
#pragma unroll
                for (int jj = 0; jj < 4; ++jj) { v4u pa, px;
#pragma unroll
                    for (int j2 = 0; j2 < 4; ++j2) { const float c0 = cwq[jj][ks][j2 >> 1][(2 * j2) & 3], c1 = cwq[jj][ks][j2 >> 1][(2 * j2 + 1) & 3];
                        pa[j2] = cvt_pk_bf16(c0 * wvA[ks][2 * j2], c1 * wvA[ks][2 * j2 + 1]); px[j2] = cvt_pk_bf16(c0 * wvX[ks][2 * j2], c1 * wvX[ks][2 * j2 + 1]); }
                    if (w == 0) { *(LAS v4u*)(L + OFF_CW + (((0 * 4 + jj) * 2 + ks) * 64 + lane) * 16) = pa; *(LAS v4u*)(L + OFF_CW + (((1 * 4 + jj) * 2 + ks) * 64 + lane) * 16) = px; } }
            float gsA = a.in[5][ce], gsX = a.in[7][ce];
#pragma unroll 1
            for (int d0 = 0; d0 < 64; d0 += 16) { float ta[16], tx[16]; f32x4 cbv[4];
#pragma unroll
                for (int d = 0; d < 16; ++d) { ta[d] = WgA[(d0 + d) * 64]; tx[d] = WgX[(d0 + d) * 64]; }
#pragma unroll
                for (int q = 0; q < 4; ++q) cbv[q] = *(const f32x4*)(a.in[3] + cblk + d0 + 4 * q);
#pragma unroll
                for (int d = 0; d < 16; ++d) { const float cbd = cbv[d >> 2][d & 3]; gsA += cbd * ta[d]; gsX += cbd * tx[d]; } }
            gbias[0] = gsA; gbias[1] = gsX;
        }
        const float cw0 = a.in[2][0 * DL + ce], cw1 = a.in[2][1 * DL + ce], cw2 = a.in[2][2 * DL + ce], cw3 = a.in[2][3 * DL + ce], cb = a.in[3][ce];
        const float bA = gbias[0], bX = gbias[1];
        const float sp8 = 8.0f * log1pf(__expf(-a.in[8][ce]));
        float carry = 0.f;
        v4u sxr[8], sxr8, sxg[2];
        const bf16_t* xrb = proj + (size_t)b * SEQ * DP + 3 * DA + cblk + (tid & 7) * 8;
        const bf16_t* xgb = proj + (size_t)b * SEQ * DP + 3 * DA + DL + cblk + q4 * 16 + (tid & 1) * 8;
#define LRU_LOAD(CH) do { const int t0_ = CHK * (CH) - 4; \
            { int t = t0_ + (tid >> 3); const bool ok = t >= 0; t = ok ? t : 0; sxr[0] = *(const v4u*)(xrb + (size_t)t * DP); if (!ok) sxr[0] = (v4u){0u, 0u, 0u, 0u}; } \
            _Pragma("unroll") for (int k = 1; k < 8; ++k) sxr[k] = *(const v4u*)(xrb + (size_t)(t0_ + 64 * k + (tid >> 3)) * DP); \
            if (tid < 32) sxr8 = *(const v4u*)(xrb + (size_t)(t0_ + 512 + (tid >> 3)) * DP); \
            _Pragma("unroll") for (int k = 0; k < 2; ++k) sxg[k] = *(const v4u*)(xgb + (size_t)(t0_ + 4 + 256 * k + (tid >> 1)) * DP); } while (0)
        LRU_LOAD(0);
        for (int chk = 0; chk < NCHK; ++chk) {
            LAS float* WT = (LAS float*)(L + OFF_WT + (chk & 1) * 1024);
            __syncthreads();
#pragma unroll
            for (int k = 0; k < 8; ++k) { const int rr = 64 * k + (tid >> 3), cc = tid & 7; *(LAS v4u*)(XR + rr * 128 + ((cc ^ (rr & 7)) << 4)) = sxr[k]; }
            if (tid < 32) { const int rr = 512 + (tid >> 3), cc = tid & 7; *(LAS v4u*)(XR + rr * 128 + ((cc ^ (rr & 7)) << 4)) = sxr8; }
#pragma unroll
            for (int k = 0; k < 2; ++k) { const int rr = 256 * k + (tid >> 1), cc = tid & 1; *(LAS v4u*)(XG + rr * 32 + cc * 16) = sxg[k]; }
            __syncthreads();
            if (chk + 1 < NCHK) LRU_LOAD(chk + 1);
            int li = i, lg = g;
            asm volatile("" : "+v"(li), "+v"(lg));
            const int llane = lg * 16 + li;
            float av[4][4], uv[4][4], Ae[4], Be[4], Agt[4], Bgt[4];
#pragma unroll
            for (int gi = 0; gi < 4; ++gi) {
                const int tb = 64 * w + 16 * gi;
                f32x4 ga = (f32x4){0.f, 0.f, 0.f, 0.f}, gx = (f32x4){0.f, 0.f, 0.f, 0.f};
#pragma unroll
                for (int jj = 0; jj < 4; ++jj)
#pragma unroll
                    for (int ks = 0; ks < 2; ++ks) { const int rr = tb + li + 1 + jj, c8 = lg + 4 * ks;
                        const bf16x8 af = *(const LAS bf16x8*)(XR + rr * 128 + ((c8 ^ (rr & 7)) << 4));
                        const bf16x8 wA = *(const LAS bf16x8*)(L + OFF_CW + (((0 * 4 + jj) * 2 + ks) * 64 + llane) * 16), wX = *(const LAS bf16x8*)(L + OFF_CW + (((1 * 4 + jj) * 2 + ks) * 64 + llane) * 16);
                        ga = __builtin_amdgcn_mfma_f32_16x16x32_bf16(af, wA, ga, 0, 0, 0);
                        gx = __builtin_amdgcn_mfma_f32_16x16x32_bf16(af, wX, gx, 0, 0, 0); }
                float r7[7];
                { const int chn = q4 * 16 + li, c8 = chn >> 3, bo = (chn & 7) * 2;
#pragma unroll
                  for (int k = 0; k < 7; ++k) { const int rr = tb + 4 * lg + 1 + k; r7[k] = bf2f(*(const LAS bf16_t*)(XR + rr * 128 + ((c8 ^ (rr & 7)) << 4) + bo)); } }
#pragma unroll
                for (int j = 0; j < 4; ++j) {
                    const float xc = cb + r7[j] * cw0 + r7[j + 1] * cw1 + r7[j + 2] * cw2 + r7[j + 3] * cw3;
                    const float r = sigm(ga[j] + bA), ig = sigm(gx[j] + bX);
                    const float la = -r * sp8;
                    av[gi][j] = __expf(la);
                    uv[gi][j] = __builtin_amdgcn_sqrtf(fmaf(-av[gi][j], av[gi][j], 1.0f)) * (ig * xc);
                }
                float A = av[gi][0], B = uv[gi][0];
#pragma unroll
                for (int j = 1; j < 4; ++j) { B = av[gi][j] * B + uv[gi][j]; A *= av[gi][j]; }
                float Ai = A, Bi = B;
                { const float Ap = __shfl_up(Ai, 16), Bp = __shfl_up(Bi, 16); if (g >= 1) { Bi = Ai * Bp + Bi; Ai = Ai * Ap; } }
                { const float Ap = __shfl_up(Ai, 32), Bp = __shfl_up(Bi, 32); if (g >= 2) { Bi = Ai * Bp + Bi; Ai = Ai * Ap; } }
                Ae[gi] = __shfl_up(Ai, 16); Be[gi] = __shfl_up(Bi, 16); if (g == 0) { Ae[gi] = 1.f; Be[gi] = 0.f; }
                Agt[gi] = __shfl(Ai, 48 + i); Bgt[gi] = __shfl(Bi, 48 + i);
            }
            float Aw_ = Agt[0], Bw_ = Bgt[0];
#pragma unroll
            for (int gi = 1; gi < 4; ++gi) { Bw_ = Agt[gi] * Bw_ + Bgt[gi]; Aw_ *= Agt[gi]; }
            if (g == 0) { WT[(w * 16 + i) * 2] = Aw_; WT[(w * 16 + i) * 2 + 1] = Bw_; }
            __syncthreads();
            float hw = carry, hall = carry;
#pragma unroll
            for (int w2 = 0; w2 < 8; ++w2) { const float Aw = WT[(w2 * 16 + i) * 2], Bw = WT[(w2 * 16 + i) * 2 + 1]; hall = Aw * hall + Bw; if (w2 < w) hw = hall; }
            carry = hall;
            bf16_t* rec = (bf16_t*)((unsigned char*)a.out + DO_REC);
            float hg = hw;
#pragma unroll
            for (int gi = 0; gi < 4; ++gi) {
                float h = Ae[gi] * hg + Be[gi];
#pragma unroll
                for (int j = 0; j < 4; ++j) {
                    h = av[gi][j] * h + uv[gi][j];
                    const int tl = 64 * w + 16 * gi + 4 * lg + j;
                    const float xg = bf2f(*(const LAS bf16_t*)(XG + tl * 32 + li * 2));
                    const float uu = 1.5957691216057308f * (xg + 0.044715f * xg * xg * xg);
                    const float rv = h * xg * sigm(uu);
                    const size_t t = (size_t)b * SEQ + CHK * chk + tl;
                    __builtin_nontemporal_store((bf16_t)f2bf(rv), rec + t * DL + ce);
                }
                hg = Agt[gi] * hg + Bgt[gi];
            }
        }
#undef LRU_LOAD
    }
}
}

#define XB_TMO      128
#define XB_XCNT(j)  (256  + 64 * (j))
#define XB_XSUB(j)  (1280 + 64 * (j))
#define XB_XGEN(j)  (2304 + 64 * (j))
#define XB_TOP      3328
#define XB_TOPGEN   3392
#define XCD_BAR_WORDS 3456
#define XB_SPIN_CAP (1u << 18)
__device__ __forceinline__ unsigned xb_ld(unsigned* p)              { return __hip_atomic_load(p, __ATOMIC_RELAXED, __HIP_MEMORY_SCOPE_AGENT); }
__device__ __forceinline__ unsigned xb_add(unsigned* p, unsigned v) { return __hip_atomic_fetch_add(p, v, __ATOMIC_RELAXED, __HIP_MEMORY_SCOPE_AGENT); }
__device__ __forceinline__ unsigned xb_xcc_id() { return (unsigned)__builtin_amdgcn_s_getreg((3 << 11) | 20) & 0xFu; }
#define XB_SPIN(cond, bar) do { unsigned _sp = 0; while (cond) { __builtin_amdgcn_s_sleep(1); \
    if ((++_sp & 255u) == 0u) { if (xb_ld(&(bar)[XB_TMO])) break; if (_sp > XB_SPIN_CAP) { atomicAdd(&(bar)[XB_TMO], 1u); break; } } } } while (0)
struct XcdBarrier { unsigned* bar; unsigned x; volatile LAS unsigned* st; };
__device__ __forceinline__ XcdBarrier xcd_barrier_post(unsigned* bar, volatile LAS unsigned* st) {
    XcdBarrier b; b.bar = bar; b.x = xb_xcc_id(); b.st = st;
    if (threadIdx.x == 0) (void)xb_add(&bar[XB_XCNT(b.x)], 1u);
    return b;
}
__device__ __forceinline__ void xcd_barrier_complete(unsigned* bar, unsigned x, unsigned& nloc, unsigned& nx) {
    const unsigned G = gridDim.x * gridDim.y * gridDim.z;
    unsigned sum, cnt, mine, sp = 0u;
    for (;;) {
        sum = 0u; cnt = 0u; mine = 0u;
#pragma unroll
        for (unsigned j = 0; j < 16; ++j) { const unsigned c = xb_ld(&bar[XB_XCNT(j)]); sum += c; cnt += (c > 0u) ? 1u : 0u; mine = (j == x) ? c : mine; }
        if (sum == G) break;
        __builtin_amdgcn_s_sleep(1);
        if ((++sp & 255u) == 0u) { if (xb_ld(&bar[XB_TMO])) break; if (sp > XB_SPIN_CAP) { atomicAdd(&bar[XB_TMO], 1u); break; } }
    }
    nloc = mine > 0u ? mine : 1u; nx = cnt > 0u ? cnt : 1u;
}
__device__ __forceinline__ void xcd_barrier(const XcdBarrier& b) {
    asm volatile("s_waitcnt vmcnt(0)" ::: "memory");
    __syncthreads();
    if (threadIdx.x == 0) {
        unsigned* bar = b.bar;
        __builtin_amdgcn_s_waitcnt(0);
        unsigned nloc = b.st[0], nx = b.st[1];
        if (nloc == 0u) { xcd_barrier_complete(bar, b.x, nloc, nx); b.st[0] = nloc; b.st[1] = nx; }
        const unsigned old = xb_add(&bar[XB_XSUB(b.x)], 1u);
        const unsigned gen = old / nloc;
        if (old + 1u == (gen + 1u) * nloc) {
            __builtin_amdgcn_fence(__ATOMIC_RELEASE, "agent");
            asm volatile("s_waitcnt vmcnt(0)" ::: "memory");
            const unsigned og = xb_add(&bar[XB_TOP], 1u);
            const unsigned tg = og / nx;
            if (og + 1u == (tg + 1u) * nx) xb_add(&bar[XB_TOPGEN], 1u);
            else XB_SPIN(xb_ld(&bar[XB_TOPGEN]) == tg, bar);
            __builtin_amdgcn_fence(__ATOMIC_ACQUIRE, "agent");
            xb_add(&bar[XB_XGEN(b.x)], 1u);
            asm volatile("s_waitcnt vmcnt(0)" ::: "memory");
        } else {
            XB_SPIN(xb_ld(&bar[XB_XGEN(b.x)]) == gen, bar);
            __builtin_amdgcn_fence(__ATOMIC_ACQUIRE, "agent");
            asm volatile("s_waitcnt vmcnt(0)" ::: "memory");
        }
    }
    __syncthreads();
}

#ifndef PROBE_PH
#define PROBE_PH -1
#endif
#define NREP(k) (((k) == PROBE_PH) ? 3 : 1)
#ifndef UP_SP2
#define UP_SP2 true
#endif
enum Phase { PH_CONVERT = 0, PH_GEMM1, PH_ATTN_LRU, PH_COMBINE, PH_GEMM2, PH_LN1, PH_MOE, PH_FINAL, PH_N };


__global__ void __launch_bounds__(NTHR, 2) mega(Args args) {
    extern __shared__ __attribute__((aligned(16))) unsigned char lds[];
    Frame F; F.lds = (LAS unsigned char*)lds; F.tid = threadIdx.x; F.lane = F.tid & 63; F.wave = __builtin_amdgcn_readfirstlane(F.tid >> 6);
    F.gw = blockIdx.x * NWAVES + F.wave; F.ngw = gridDim.x * NWAVES;
#define FRAME(Fn) Frame Fn; { int t_ = threadIdx.x; asm volatile("" : "+v"(t_)); Fn.lds = (LAS unsigned char*)lds; Fn.tid = t_; Fn.lane = t_ & 63; Fn.wave = __builtin_amdgcn_readfirstlane(t_ >> 6); \
        Fn.gw = blockIdx.x * NWAVES + Fn.wave; Fn.ngw = gridDim.x * NWAVES; }
    const int lo = args.lo, hi = args.hi;
    volatile LAS unsigned* bst = (volatile LAS unsigned*)(F.lds + BARST_OFF);
    if (F.tid < 4) bst[F.tid] = 0u;
    __syncthreads();
    XcdBarrier bar; bar.bar = (unsigned*)(args.ws + WS_CTL) + CW_BAR; bar.x = 0; bar.st = bst;
    if (hi - lo > 1) bar = xcd_barrier_post((unsigned*)(args.ws + WS_CTL) + CW_BAR, bst);
#define IN(k) (lo <= (k) && (k) < hi)
#define SEAM(k) do { if (IN(k) && IN((k) + 1)) xcd_barrier(bar); } while (0)
    if (IN(PH_CONVERT)) phase_convert(F, args);
    SEAM(PH_CONVERT);
    if (IN(PH_GEMM1)) {
        const int cls = ((int)blockIdx.x >> 3) & 3, ks = (cls == 0) ? 0 : (cls == 1 ? 1 : (cls == 2 ? 3 : (1 << 29)));
        g8::ProbProj P; P.A = (const char*)(args.ws + WS_D); P.Bt = (const char*)(args.ws + WS_WIN); P.C = (bf16_t*)(args.ws + WS_B); P.ord.init(T, DP, gridDim.x, blockIdx.x);
        P.ord.i0 = 0; P.ord.i1 = ks;
        g8::gemm_phase(F.lds, P);
        __syncthreads();
        convert_rest(F, args);
        __syncthreads();
        P.ord.i0 = ks; P.ord.i1 = 1 << 30;
        g8::gemm_phase(F.lds, P);
    }
    SEAM(PH_GEMM1);
    if (IN(PH_ATTN_LRU)) { lru::lru_phase(F, args); att::attn_phase(F, args); }
    SEAM(PH_ATTN_LRU);
    if (IN(PH_COMBINE)) phase_combine(F, args);
    SEAM(PH_COMBINE);
#define DO_GEMM2() {         g8::ProbOut P; P.A = (const char*)(args.ws + WS_Y); P.Bt = (const char*)(args.ws + WS_WOUT); P.C = (bf16_t*)(args.ws + WS_B); P.ord.init(T, D, gridDim.x, blockIdx.x);         g8::gemm_phase(F.lds, P);     }
    if (IN(PH_GEMM2)) { DO_GEMM2(); if (NREP(PH_GEMM2) > 1) { DO_GEMM2(); DO_GEMM2(); } }
    SEAM(PH_GEMM2);
    if (IN(PH_LN1)) phase_ln1_router(F, args);
    SEAM(PH_LN1);
    if (IN(PH_MOE) || IN(PH_FINAL)) {
        LAS int* toff = (LAS int*)(F.lds + MISC_OFF);
        const unsigned* cnt = (const unsigned*)(args.ws + WS_CTL) + CW_CNT;
        if (F.tid == 0) { int acc = 0; for (int e = 0; e < NE; ++e) { const int c = (int)cnt[e]; toff[e] = acc; toff[64 + e] = c; acc += (c + 255) >> 8; } toff[NE] = acc; toff[128 + 3] = -1; }
        __syncthreads();
    }
    if (IN(PH_MOE)) {
        g8::MoeQueue Q; Q.toff = (const LAS int*)(F.lds + MISC_OFF); Q.slots = (LAS int*)(F.lds + MISC_OFF + 512);
        Q.qhead = (unsigned*)(args.ws + WS_CTL) + CW_QHEAD; Q.ready = (unsigned*)(args.ws + WS_CTL) + CW_READY; Q.tmo = (unsigned*)(args.ws + WS_CTL) + CW_BAR + XB_TMO;
        {
            g8::ProbUp P; P.A = (const char*)(args.ws + WS_X8); P.Bt = (const char*)(args.ws + WS_W13); P.H = (unsigned char*)(args.ws + WS_D); P.rowtok = (const int*)(args.ws + WS_ROUTE + RT_ROWTOK); P.q = Q;
            g8::gemm_phase<g8::ProbUp, UP_SP2>(F.lds, P);
        }
        {
            g8::ProbDown P; P.A = (const char*)(args.ws + WS_D); P.Bt = (const char*)(args.ws + WS_W2); P.Y = (unsigned char*)(args.ws + WS_B); P.q = Q;
            g8::gemm_phase(F.lds, P);
        }
    }
    SEAM(PH_MOE);
    if (IN(PH_FINAL)) phase_final(F, args);
#undef IN
#undef SEAM
}

extern "C" void kernel_launch(void* const* d_in, const int* in_sizes, int n_in, void* d_out, int out_size, void* d_ws, size_t ws_size, hipStream_t stream) {
    static int grid = 0;
    if (grid == 0) {
        if (n_in != 23 || out_size != T * D || ws_size < WS_END) { fprintf(stderr, "kernel_launch: unexpected shapes (n_in %d out %d ws %zu)\n", n_in, out_size, ws_size); grid = -1; return; }
        int dev = 0, cus = 0;
        if (hipGetDevice(&dev) != hipSuccess || hipDeviceGetAttribute(&cus, hipDeviceAttributeMultiprocessorCount, dev) != hipSuccess) { grid = -1; return; }
        if (hipFuncSetAttribute((const void*)mega, hipFuncAttributeMaxDynamicSharedMemorySize, LDS_BYTES) != hipSuccess) { grid = -1; return; }
        grid = cus;
    }
    if (grid < 0) return;
    (void)in_sizes;
    hipMemsetAsync((char*)d_ws + WS_CTL, 0, CTL_BYTES, stream);
    Args a{};
    for (int i = 0; i < 23; ++i) a.in[i] = (const float*)d_in[i];
    a.out = (float*)d_out; a.ws = (unsigned char*)d_ws; a.lo = 0; a.hi = 0;
    auto run = [&](int lo, int hi) { a.lo = lo; a.hi = hi; hipLaunchKernelGGL(mega, dim3(grid), dim3(NTHR), LDS_BYTES, stream, a); };
#if defined(MK_PER_PHASE)
    for (int ph = 0; ph < PH_N; ++ph) run(ph, ph + 1);
#else
    run(0, PH_N);
#endif
}
```
